# Optimizing an MI355X kernel written in HIP

```python
import math
import jax
import jax.numpy as jnp
from jax import lax
import numpy as np

D_MODEL = 2048
BATCH = 4
SEQ = 4096
DEPTH = 2

GRID_W = 64
CTX_LEN = 256
N_EVEN = (DEPTH + 1) // 2
N_ODD = DEPTH // 2
EPS = 1e-6

HY_WIDTH = D_MODEL // 2
HY_ORDER = 2
HY_SHORT = 3
HY_BANDS = 16
HY_EMB = 2 * HY_BANDS + 1
HY_FFN = 64
HY_TARGET = 1e-2
HY_FAST_PCT = 0.3
HY_SLOW_PCT = 1.5

S5_WIDTH = D_MODEL // 2
S5_GROUP = 16
S5_GROUPS = S5_WIDTH // S5_GROUP
S5_STATE = 64
S5_DT_MIN = 1e-3
S5_DT_MAX = 1e-1

EVEN_IN = (HY_ORDER + 2) * HY_WIDTH + 2 * S5_WIDTH
EVEN_MIX = HY_WIDTH + S5_WIDTH

DA_HEAD = 64
DA_HEADS = D_MODEL // (2 * DA_HEAD)
DA_QK = DA_HEADS * 2 * DA_HEAD
DA_V = DA_HEADS * 2 * DA_HEAD
ODD_IN = 2 * DA_QK + 2 * DA_V
Q_BLOCK = 128
ROPE_BASE = 10000.0

kernel_name = 'hybrid_hyena_s5_diffattn_dit'


def rms_norm(x, w):
    xf = x.astype(jnp.float32)
    y = xf * lax.rsqrt(jnp.mean(xf * xf, axis=-1, keepdims=True) + EPS)
    return (y * w.astype(jnp.float32)).astype(x.dtype)


def short_conv(u, w, b):
    n = u.shape[1]
    pad = HY_SHORT // 2
    up = jnp.pad(u, ((0, 0), (pad, pad), (0, 0)))
    return sum(up[:, j:j + n] * w[j] for j in range(HY_SHORT)) + b


def hyena_filters(n, w1, b1, w2, b2, w3, b3, freq):
    f32 = jnp.float32
    t = jnp.arange(n, dtype=f32)
    tn = t / n
    bands = jnp.linspace(1e-4, HY_BANDS - 1, HY_BANDS, dtype=f32)
    ang = (2.0 * math.pi / n) * t[:, None] * bands[None, :]
    feat = jnp.concatenate([tn[:, None], jnp.cos(ang), -jnp.sin(ang)], axis=-1)
    h = jnp.sin(freq[0].astype(f32) * (feat @ w1.astype(f32) + b1.astype(f32)))
    h = jnp.sin(freq[1].astype(f32) * (h @ w2.astype(f32) + b2.astype(f32)))
    h = (h @ w3.astype(f32) + b3.astype(f32)).reshape(n, HY_ORDER, 2, HY_WIDTH)
    deltas = jnp.abs(jnp.linspace(math.log(HY_TARGET) / HY_SLOW_PCT, math.log(HY_TARGET) / HY_FAST_PCT, HY_WIDTH, dtype=f32))
    h = h * jnp.exp(-tn[:, None] * deltas[None, :])[:, None, None, :]
    h_fwd = h[:, :, 0]
    h_bwd = h[1:, :, 1]
    l1 = jnp.sum(jnp.abs(h_fwd), axis=0) + jnp.sum(jnp.abs(h_bwd), axis=0)
    k = jnp.concatenate([h_fwd, jnp.zeros((1, HY_ORDER, HY_WIDTH), f32), h_bwd[::-1]], axis=0) / l1
    return jnp.fft.rfft(k, axis=0)


def fft_long_conv(u, kf, skip):
    n = u.shape[1]
    uf32 = u.astype(jnp.float32)
    uf = jnp.fft.rfft(uf32, n=2 * n, axis=1)
    y = jnp.fft.irfft(uf * kf[None], n=2 * n, axis=1)[:, :n]
    return y + uf32 * skip.astype(jnp.float32)


def hyena(proj, conv_w, conv_b, filt, skip):
    n = proj.shape[1]
    parts = jnp.split(short_conv(proj, conv_w, conv_b), HY_ORDER + 1, axis=-1)
    kf = hyena_filters(n, *filt)
    y = parts[0]
    for i in range(HY_ORDER):
        y = parts[i + 1].astype(jnp.float32) * fft_long_conv(y, kf[:, i], skip[i])
    return y.astype(proj.dtype)


def s5_discretise(a_re, a_im, log_dt, b_re, b_im):
    f32 = jnp.float32
    lam = lax.complex(a_re.astype(f32), a_im.astype(f32))
    dt = jnp.exp(log_dt.astype(f32))[:, None]
    lam_bar = jnp.exp(lam * dt)
    b = lax.complex(b_re.astype(f32), b_im.astype(f32))
    b_bar = ((lam_bar - 1.0) / lam)[..., None] * b
    return lam_bar, b_bar


def s5_scan(u, lam_bar, b_bar, s0, reverse):
    n = u.shape[1]
    bu = jnp.einsum('bngc,gpc->bngp', u.astype(jnp.complex64), b_bar)
    first = n - 1 if reverse else 0
    last = 0 if reverse else n - 1
    bu = bu.at[:, first].add(lam_bar[None] * s0)
    a = jnp.broadcast_to(lam_bar, (1,) + bu.shape[1:])

    def combine(e1, e2):
        a1, b1 = e1
        a2, b2 = e2
        return a2 * a1, a2 * b1 + b2

    _, states = lax.associative_scan(combine, (a, bu), reverse=reverse, axis=1)
    return states, states[:, last]


def s5_branch(u_ctx, u_lat, a_re, a_im, log_dt, b_re, b_im, c_re, c_im, d):
    f32 = jnp.float32
    bsz, n_ctx, _ = u_ctx.shape
    n_lat = u_lat.shape[1]
    uc = u_ctx.astype(f32)
    ul = u_lat.astype(f32)
    dd = d.astype(f32)
    y_ctx = uc * dd
    y_lat = ul * dd
    uc_g = uc.reshape(bsz, n_ctx, S5_GROUPS, S5_GROUP)
    ul_g = ul.reshape(bsz, n_lat, S5_GROUPS, S5_GROUP)
    s_zero = jnp.zeros((bsz, S5_GROUPS, S5_STATE), jnp.complex64)
    for direction, reverse in ((0, False), (1, True)):
        lam_bar, b_bar = s5_discretise(a_re[direction], a_im[direction], log_dt[direction], b_re[direction], b_im[direction])
        c_mat = lax.complex(c_re[direction].astype(f32), c_im[direction].astype(f32))
        st_c, s_fin = s5_scan(uc_g, lam_bar, b_bar, s_zero, reverse)
        st_l = s5_scan(ul_g, lam_bar, b_bar, s_fin, reverse)[0]
        y_ctx = y_ctx + jnp.real(jnp.einsum('bngp,gcp->bngc', st_c, c_mat)).reshape(bsz, n_ctx, S5_WIDTH)
        y_lat = y_lat + jnp.real(jnp.einsum('bngp,gcp->bngc', st_l, c_mat)).reshape(bsz, n_lat, S5_WIDTH)
    return y_ctx, y_lat


def s5_glu(y, w, b):
    g = jax.nn.gelu(y)
    return g * jax.nn.sigmoid(g @ w.astype(jnp.float32) + b.astype(jnp.float32))


def even_mixer(h_lat, h_ctx, in_w, out_w, conv_w, conv_b, w1, b1, w2, b2, w3, b3, freq, skip,
               a_re, a_im, log_dt, b_re, b_im, c_re, c_im, d, glu_w, glu_b):
    cuts = [(HY_ORDER + 1) * HY_WIDTH, (HY_ORDER + 2) * HY_WIDTH, (HY_ORDER + 2) * HY_WIDTH + S5_WIDTH]
    hp_l, hg_l, su_l, sg_l = jnp.split(h_lat @ in_w, cuts, axis=-1)
    hp_c, hg_c, su_c, sg_c = jnp.split(h_ctx @ in_w, cuts, axis=-1)
    filt = (w1, b1, w2, b2, w3, b3, freq)
    hy_l = hyena(hp_l, conv_w, conv_b, filt, skip)
    hy_c = hyena(hp_c, conv_w, conv_b, filt, skip)
    s5_c, s5_l = s5_branch(su_c, su_l, a_re, a_im, log_dt, b_re, b_im, c_re, c_im, d)
    s5_l = s5_glu(s5_l, glu_w, glu_b)
    s5_c = s5_glu(s5_c, glu_w, glu_b)

    def merge(hy, hg, s5, sg):
        mixed = jnp.concatenate([hy * jax.nn.silu(hg), s5.astype(hy.dtype) * jax.nn.silu(sg)], axis=-1)
        return mixed @ out_w

    return merge(hy_l, hg_l, s5_l, sg_l), merge(hy_c, hg_c, s5_c, sg_c)


def rope_2d(x):
    f32 = jnp.float32
    n = x.shape[1]
    rows = n // GRID_W
    row = jnp.broadcast_to(jnp.arange(rows, dtype=f32)[:, None], (rows, GRID_W)).reshape(n)
    col = jnp.broadcast_to(jnp.arange(GRID_W, dtype=f32)[None, :], (rows, GRID_W)).reshape(n)
    half = DA_HEAD // 2
    quarter = DA_HEAD // 4
    freqs = ROPE_BASE ** (-jnp.arange(quarter, dtype=f32) / quarter)
    xf = x.astype(f32)

    def rot(xa, pos):
        ang = pos[:, None] * freqs[None, :]
        cos = jnp.cos(ang)[None, :, None, None, :]
        sin = jnp.sin(ang)[None, :, None, None, :]
        x1, x2 = xa[..., :quarter], xa[..., quarter:]
        return jnp.concatenate([x1 * cos - x2 * sin, x1 * sin + x2 * cos], axis=-1)

    return jnp.concatenate([rot(xf[..., :half], row), rot(xf[..., half:], col)], axis=-1).astype(x.dtype)


def diff_attend(q, k, v, lam):
    s = jnp.einsum('bqhmd,bkhmd->bhmqk', q.astype(jnp.float32), k.astype(jnp.float32)) * (DA_HEAD ** -0.5)
    p = jax.nn.softmax(s, axis=-1)
    w = p[:, :, 0] - lam * p[:, :, 1]
    return jnp.einsum('bhqk,bkhe->bqhe', w, v.astype(jnp.float32))


def odd_mixer(h_lat, h_ctx, layer, need_ctx, in_w, out_w, q_norm, k_norm, lq1, lk1, lq2, lk2, subln_w):
    f32 = jnp.float32
    bsz, n_lat, _ = h_lat.shape
    n_ctx = h_ctx.shape[1]
    lam_init = 0.8 - 0.6 * math.exp(-0.3 * layer)
    lam = (jnp.exp(jnp.sum(lq1.astype(f32) * lk1.astype(f32)))
           - jnp.exp(jnp.sum(lq2.astype(f32) * lk2.astype(f32))) + lam_init)

    def qk_shape(t, n):
        return t.reshape(bsz, n, DA_HEADS, 2, DA_HEAD)

    def v_shape(t, n):
        return t.reshape(bsz, n, DA_HEADS, 2 * DA_HEAD)

    cuts = [DA_QK, 2 * DA_QK, 2 * DA_QK + DA_V]
    q_l, k_l, v_l, g_l = jnp.split(h_lat @ in_w, cuts, axis=-1)
    q_l = rope_2d(rms_norm(qk_shape(q_l, n_lat), q_norm))
    k_l = rope_2d(rms_norm(qk_shape(k_l, n_lat), k_norm))
    v_l = v_shape(v_l, n_lat)
    if need_ctx:
        q_c, k_c, v_c, g_c = jnp.split(h_ctx @ in_w, cuts, axis=-1)
    else:
        k_c, v_c = jnp.split(h_ctx @ in_w[:, DA_QK:2 * DA_QK + DA_V], [DA_QK], axis=-1)
    k_c = rms_norm(qk_shape(k_c, n_ctx), k_norm)
    v_c = v_shape(v_c, n_ctx)
    k_all = jnp.concatenate([k_c, k_l], axis=1)
    v_all = jnp.concatenate([v_c, v_l], axis=1)
    n_blk = n_lat // Q_BLOCK
    q_blocks = q_l.reshape(bsz, n_blk, Q_BLOCK, DA_HEADS, 2, DA_HEAD).transpose(1, 0, 2, 3, 4, 5)
    o_l = lax.map(lambda qb: diff_attend(qb, k_all, v_all, lam), q_blocks)
    o_l = o_l.transpose(1, 0, 2, 3, 4).reshape(bsz, n_lat, DA_HEADS, 2 * DA_HEAD)

    def post(o, g):
        o = rms_norm(o, subln_w) * (1.0 - lam_init)
        o = o.reshape(bsz, o.shape[1], DA_V).astype(g.dtype) * jax.nn.silu(g)
        return o @ out_w

    out_l = post(o_l, g_l)
    if need_ctx:
        q_c = rms_norm(qk_shape(q_c, n_ctx), q_norm)
        out_c = post(diff_attend(q_c, k_c, v_c, lam), g_c)
    else:
        out_c = None
    return out_l, out_c


def setup_inputs(seed: int = 0) -> dict:
    key = jax.random.key(seed)
    keys = iter(jax.random.split(key, 64))
    f32 = jnp.float32

    def nrm(shape, scale):
        return jax.random.normal(next(keys), shape, f32) * scale

    D = D_MODEL
    x = nrm((BATCH, SEQ, D), 1.0)
    c = nrm((BATCH, D), 1.0)
    ctx = nrm((BATCH, CTX_LEN, D), 1.0)
    c_ctx = nrm((D,), 1.0)
    mod_w = nrm((DEPTH, D, 3 * D), 0.5 * D ** -0.5)
    mod_b = nrm((DEPTH, 3 * D), 0.02)
    norm_w = 1.0 + nrm((DEPTH, D), 0.02)
    ev_in_w = nrm((N_EVEN, D, EVEN_IN), D ** -0.5)
    ev_out_w = nrm((N_EVEN, EVEN_MIX, D), EVEN_MIX ** -0.5)
    hy_conv_w = nrm((N_EVEN, HY_SHORT, (HY_ORDER + 1) * HY_WIDTH), HY_SHORT ** -0.5)
    hy_conv_b = nrm((N_EVEN, (HY_ORDER + 1) * HY_WIDTH), 0.02)
    hy_w1 = nrm((N_EVEN, HY_EMB, HY_FFN), HY_EMB ** -0.5)
    hy_b1 = nrm((N_EVEN, HY_FFN), 0.02)
    hy_w2 = nrm((N_EVEN, HY_FFN, HY_FFN), HY_FFN ** -0.5)
    hy_b2 = nrm((N_EVEN, HY_FFN), 0.02)
    hy_w3 = nrm((N_EVEN, HY_FFN, HY_ORDER * 2 * HY_WIDTH), HY_FFN ** -0.5)
    hy_b3 = nrm((N_EVEN, HY_ORDER * 2 * HY_WIDTH), 0.02)
    hy_freq = 1.0 + nrm((N_EVEN, 2, HY_FFN), 0.02)
    hy_skip = nrm((N_EVEN, HY_ORDER, HY_WIDTH), 0.5)
    s5_a_re = -0.5 + nrm((N_EVEN, 2, S5_GROUPS, S5_STATE), 0.01)
    s5_a_im = math.pi * jnp.arange(S5_STATE, dtype=f32) + nrm((N_EVEN, 2, S5_GROUPS, S5_STATE), 0.01)
    s5_log_dt = math.log(S5_DT_MIN) + jax.random.uniform(next(keys), (N_EVEN, 2, S5_GROUPS), f32) * (math.log(S5_DT_MAX) - math.log(S5_DT_MIN))
    s5_b_re = nrm((N_EVEN, 2, S5_GROUPS, S5_STATE, S5_GROUP), (2 * S5_GROUP) ** -0.5)
    s5_b_im = nrm((N_EVEN, 2, S5_GROUPS, S5_STATE, S5_GROUP), (2 * S5_GROUP) ** -0.5)
    s5_c_re = nrm((N_EVEN, 2, S5_GROUPS, S5_GROUP, S5_STATE), (2 * S5_STATE) ** -0.5)
    s5_c_im = nrm((N_EVEN, 2, S5_GROUPS, S5_GROUP, S5_STATE), (2 * S5_STATE) ** -0.5)
    s5_d = nrm((N_EVEN, S5_WIDTH), 1.0)
    s5_glu_w = nrm((N_EVEN, S5_WIDTH, S5_WIDTH), S5_WIDTH ** -0.5)
    s5_glu_b = nrm((N_EVEN, S5_WIDTH), 0.02)
    od_in_w = nrm((N_ODD, D, ODD_IN), D ** -0.5)
    od_out_w = nrm((N_ODD, DA_V, D), DA_V ** -0.5)
    da_q_norm = 1.0 + nrm((N_ODD, DA_HEAD), 0.02)
    da_k_norm = 1.0 + nrm((N_ODD, DA_HEAD), 0.02)
    da_lq1 = nrm((N_ODD, DA_HEAD), 0.1)
    da_lk1 = nrm((N_ODD, DA_HEAD), 0.1)
    da_lq2 = nrm((N_ODD, DA_HEAD), 0.1)
    da_lk2 = nrm((N_ODD, DA_HEAD), 0.1)
    da_subln = 1.0 + nrm((N_ODD, 2 * DA_HEAD), 0.02)
    return {'x': x, 'c': c, 'ctx': ctx, 'c_ctx': c_ctx,
            'mod_w': mod_w, 'mod_b': mod_b, 'norm_w': norm_w,
            'ev_in_w': ev_in_w, 'ev_out_w': ev_out_w,
            'hy_conv_w': hy_conv_w, 'hy_conv_b': hy_conv_b,
            'hy_w1': hy_w1, 'hy_b1': hy_b1, 'hy_w2': hy_w2, 'hy_b2': hy_b2, 'hy_w3': hy_w3, 'hy_b3': hy_b3,
            'hy_freq': hy_freq, 'hy_skip': hy_skip,
            's5_a_re': s5_a_re, 's5_a_im': s5_a_im, 's5_log_dt': s5_log_dt,
            's5_b_re': s5_b_re, 's5_b_im': s5_b_im, 's5_c_re': s5_c_re, 's5_c_im': s5_c_im,
            's5_d': s5_d, 's5_glu_w': s5_glu_w, 's5_glu_b': s5_glu_b,
            'od_in_w': od_in_w, 'od_out_w': od_out_w, 'da_q_norm': da_q_norm, 'da_k_norm': da_k_norm,
            'da_lq1': da_lq1, 'da_lk1': da_lk1, 'da_lq2': da_lq2, 'da_lk2': da_lk2, 'da_subln': da_subln}


def reference(x, c, ctx, c_ctx, mod_w, mod_b, norm_w, ev_in_w, ev_out_w, hy_conv_w, hy_conv_b,
              hy_w1, hy_b1, hy_w2, hy_b2, hy_w3, hy_b3, hy_freq, hy_skip,
              s5_a_re, s5_a_im, s5_log_dt, s5_b_re, s5_b_im, s5_c_re, s5_c_im, s5_d, s5_glu_w, s5_glu_b,
              od_in_w, od_out_w, da_q_norm, da_k_norm, da_lq1, da_lk1, da_lq2, da_lk2, da_subln):
    for layer in range(DEPTH):
        last = layer == DEPTH - 1
        i = layer // 2
        mod = jax.nn.silu(c) @ mod_w[layer] + mod_b[layer]
        mod_c = jax.nn.silu(c_ctx) @ mod_w[layer] + mod_b[layer]
        shift, scale, gate = jnp.split(mod, 3, axis=-1)
        shift_c, scale_c, gate_c = jnp.split(mod_c, 3, axis=-1)
        h_lat = rms_norm(x, norm_w[layer]) * (1.0 + scale[:, None, :]) + shift[:, None, :]
        h_ctx = rms_norm(ctx, norm_w[layer]) * (1.0 + scale_c) + shift_c
        if layer % 2 == 0:
            out_l, out_c = even_mixer(h_lat, h_ctx, ev_in_w[i], ev_out_w[i], hy_conv_w[i], hy_conv_b[i],
                                      hy_w1[i], hy_b1[i], hy_w2[i], hy_b2[i], hy_w3[i], hy_b3[i], hy_freq[i], hy_skip[i],
                                      s5_a_re[i], s5_a_im[i], s5_log_dt[i], s5_b_re[i], s5_b_im[i],
                                      s5_c_re[i], s5_c_im[i], s5_d[i], s5_glu_w[i], s5_glu_b[i])
        else:
            out_l, out_c = odd_mixer(h_lat, h_ctx, layer, not last, od_in_w[i], od_out_w[i],
                                     da_q_norm[i], da_k_norm[i], da_lq1[i], da_lk1[i], da_lq2[i], da_lk2[i], da_subln[i])
        x = x + gate[:, None, :] * out_l
        if not last:
            ctx = ctx + gate_c * out_c
    return x
```

```cpp
#include <hip/hip_runtime.h>
#include <hip/hip_cooperative_groups.h>
#include <cstdio>
#include <cstdint>
#include <cmath>
namespace cg = cooperative_groups;

#define LAS __attribute__((address_space(3)))
#define DI __device__ __forceinline__
typedef unsigned short bf16_t;
typedef short bf16x8 __attribute__((ext_vector_type(8)));
typedef float f32x4 __attribute__((ext_vector_type(4)));
typedef float f32x16 __attribute__((ext_vector_type(16)));
typedef unsigned u32x4 __attribute__((ext_vector_type(4)));
typedef unsigned u32x2 __attribute__((ext_vector_type(2)));
typedef float f32x2_t __attribute__((ext_vector_type(2)));
typedef __bf16 bf16x2_t __attribute__((ext_vector_type(2)));

DI unsigned cvtpk(float lo, float hi) { f32x2_t v = {lo, hi}; bf16x2_t b = __builtin_convertvector(v, bf16x2_t); return __builtin_bit_cast(unsigned, b); }
DI unsigned f2bf(float f) { return cvtpk(f, 0.f) & 0xffffu; }
DI float bf2f(unsigned short h) { return __uint_as_float(((unsigned)h) << 16); }
DI float bflo(unsigned w) { return __uint_as_float(w << 16); }
DI float bfhi(unsigned w) { return __uint_as_float(w & 0xffff0000u); }
DI float sigmoidf_(float x) { return __builtin_amdgcn_rcpf(1.f + __expf(-x)); }
DI float siluf_(float x) { return x * __builtin_amdgcn_rcpf(1.f + __expf(-x)); }
DI float gelu_tanh(float x) { const float u = 0.7978845608028654f * (x + 0.044715f * x * x * x); const float t = 1.f - 2.f * __builtin_amdgcn_rcpf(1.f + __expf(2.f * u)); return 0.5f * x * (1.f + t); }
DI int tid_opaque() { int t = threadIdx.x; asm volatile("" : "+v"(t)); return t; }
DI float wave_sum(float v) {
#pragma unroll
    for (int o = 1; o < 64; o <<= 1) v += __shfl_xor(v, o);
    return v;
}

constexpr int DM = 2048, NB = 4, SEQ = 4096, CTXL = 256;
constexpr int MLAT = NB * SEQ;
constexpr int MCTX = NB * CTXL;
constexpr int MTOT = MLAT + MCTX;
constexpr int EVEN_IN = 6144, ODD_IN = 8192;
constexpr float EPS = 1e-6f;
constexpr int NTHREADS = 512, NWAVES = 8;
constexpr int LDS_BYTES = 147456;
constexpr int REP_ATTN = 1, REP_HY = 1, REP_P1M = 1, REP_P3B = 1, REP_P6 = 1, REP_P57 = 1, REP_P2 = 1, EXTRA_SYNC = 0;

constexpr size_t MiB = 1u << 20;
constexpr size_t WS_CTL = 0;
constexpr size_t CTL_ZERO_BYTES = 1 * MiB;
constexpr size_t OFF_MOD = 4096;
constexpr size_t OFF_L1 = 512 * 1024;
constexpr size_t OFF_BAR = 600 * 1024;
constexpr size_t WS_EVIN_T = 1 * MiB;
constexpr size_t WS_EVOUT_T = WS_EVIN_T + (size_t)6144 * 2048 * 2;
constexpr size_t WS_GLU_T = WS_EVOUT_T + (size_t)2048 * 2048 * 2;
constexpr size_t WS_H2 = WS_GLU_T + (size_t)1024 * 1024 * 2;
constexpr size_t WS_ROPE = WS_H2 + (size_t)4352 * 64 * 4;
constexpr size_t WS_LAML = WS_ROPE + 8192;
constexpr size_t WS_L1P = WS_LAML + 64 * 1024;
static_assert(WS_L1P + 136 * 4096 * 4 <= 40 * MiB, "ws map");
constexpr size_t WS_REGION2 = 40 * MiB;
constexpr int GLAT_LEN = 8448, GCTX_LEN = 768;
constexpr size_t WS_GLAT = WS_REGION2;
constexpr size_t WS_GCTX = WS_GLAT + (size_t)2 * 1024 * GLAT_LEN * 2;
constexpr size_t WS_OPA1 = WS_GCTX + (size_t)2 * 1024 * GCTX_LEN * 2;
constexpr size_t WS_OPA3 = WS_OPA1 + (size_t)64 * 256 * 256 * 2;
constexpr size_t WS_REGION2_END = WS_OPA3 + (size_t)64 * 256 * 512 * 2;
constexpr size_t WS_ODIN_T = WS_REGION2;
constexpr size_t WS_ODOUT_T = WS_ODIN_T + (size_t)8192 * 2048 * 2;
static_assert(WS_ODOUT_T + (size_t)2048 * 2048 * 2 <= WS_REGION2_END, "region2 overlay");
constexpr size_t WS_CTX1 = 104 * MiB;
constexpr size_t WS_HN = 112 * MiB;
static_assert(WS_REGION2_END <= WS_CTX1, "ws map");
constexpr size_t WS_E = WS_HN;
constexpr size_t WS_HPT = WS_HN + (size_t)MTOT * 2048 * 2;
constexpr size_t WS_SG = WS_HPT + (size_t)4096 * MTOT * 2;
constexpr size_t WS_A3 = WS_SG + (size_t)MTOT * 1024 * 2;
constexpr size_t WS_MIXED = WS_A3 + (size_t)64 * 1280 * 512 * 2;
constexpr size_t WS_GB = WS_HN;
constexpr size_t WS_L0_END = WS_MIXED + (size_t)MTOT * 2048 * 2;
constexpr size_t WS_Q = WS_HPT;
constexpr size_t WS_K = WS_Q + (size_t)4 * 16 * 2 * 4096 * 64 * 2;
constexpr size_t WS_VT = WS_K + (size_t)4 * 16 * 2 * 4352 * 64 * 2;
constexpr size_t WS_GATE1 = WS_VT + (size_t)4 * 16 * 128 * 4352 * 2;
constexpr size_t WS_AO = WS_GATE1 + (size_t)MLAT * 2048 * 2;
constexpr size_t WS_L1_END = WS_AO + (size_t)MLAT * 2048 * 2;
constexpr size_t WS_NEED = (WS_L0_END > WS_L1_END ? WS_L0_END : WS_L1_END);
static_assert(WS_NEED <= (size_t)536870912, "ws budget");

namespace pg8 {
constexpr int BM = 256, BK = 64, HALF = 128, HTB = HALF * BK * 2, STAGE_BYTES = 8 * HTB, NXCD = 8, WGM = 8;
__host__ __device__ __forceinline__ int lds_byte(int r, int c) { const int st = (r >> 4) * 2 + (c >> 5), rr = r & 15, cc = c & 31, ob = rr * 64 + cc * 2; return st * 1024 + (ob ^ (((ob >> 9) & 1) << 5)); }
__host__ __device__ __forceinline__ void stage_rc(int b, int& R, int& C) { const int st = b / 1024, sb = b % 1024, swz = sb ^ (((sb >> 9) & 1) << 5); R = (st >> 1) * 16 + swz / 64; C = (st & 1) * 32 + (swz % 64) / 2; }
__host__ __device__ __forceinline__ int perm32(int rho) { const int n = rho >> 4, i = rho & 15; return 8 * (i >> 2) + 4 * n + (i & 3); }

struct Unit { int pm, pn, kind; };
struct Gemm { const bf16_t* A; const bf16_t* Bt; int lda, ldb, K; const bf16_t* A1; const bf16_t* Bt1; const bf16_t* A2; const bf16_t* Bt2; };

struct StaticOrder {
    int nM, nN, nwg, G, c;
    __device__ void init(int M, int N, int G_, int c_) { nM = M / BM; nN = N / BM; nwg = nM * nN; G = G_; c = c_; }
    __device__ bool next(int i, Unit& u) const { return map((long)i * G + c, u); }
    __device__ bool map(long L, Unit& u) const {
        if (L >= nwg) return false; u.kind = 0;
        int wgid = (int)L; { const int q = nwg / NXCD, r = nwg % NXCD, xcd = wgid % NXCD, off = wgid / NXCD; wgid = (xcd < r ? xcd * (q + 1) : r * (q + 1) + (xcd - r) * q) + off; }
        const int nig = WGM * nN, gid = wgid / nig, fm = gid * WGM, gsz = (nM - fm) < WGM ? (nM - fm) : WGM;
        u.pm = fm + ((wgid % nig) % gsz); u.pn = (wgid % nig) / gsz; return true;
    }
};
struct S5Order {
    int G, c;
    __device__ bool next(int i, Unit& u) const { const int L = i * G + c; if (L >= 320) return false; const int g = L / 5, t = L % 5; u.pm = g * 5 + t; u.pn = g; u.kind = 0; return true; }
};

template <class Epi, class Sched>
__device__ __forceinline__ void gemm_phase(LAS unsigned char* lds, const Gemm g, const Sched& S, const Epi& E) {
    const int tid = tid_opaque(), wid = __builtin_amdgcn_readfirstlane(tid >> 6), lane = tid & 63, wr = wid >> 2, wc = wid & 3, fr = lane & 15, fq = lane >> 4;
    const int K = g.K, nt = K / BK;
    unsigned voffA[2], voffB[2];
#pragma unroll
    for (int i = 0; i < 2; ++i) { int R, C; stage_rc(tid * 16 + i * 8192, R, C); const int Rb = Epi::PERM ? ((R & ~31) + perm32(R & 31)) : R;
        voffA[i] = (unsigned)(R * g.lda + C) * 2u; voffB[i] = (unsigned)(Rb * g.ldb + C) * 2u; }
    const size_t kstep = (size_t)(BK * 2);
    const size_t hstepA = (size_t)HALF * g.lda * 2, hstepB = (size_t)HALF * g.ldb * 2;
    const size_t tstepA = 2 * hstepA, tstepB = 2 * hstepB;
    const unsigned ldsw = (unsigned)wid * 1024u;
    const int aoff = lds_byte(wr * 64 + fr, fq * 8), boff = lds_byte(wc * 32 + fr, fq * 8);
#define PG8_SA(b, h) (((b) * 2 + (h)) * HTB)
#define PG8_SB(b, h) ((4 + (b) * 2 + (h)) * HTB)
#define PG8_STAGE(bufoff, gbase, voff) do { _Pragma("unroll") for (int _i = 0; _i < 2; ++_i) \
        __builtin_amdgcn_global_load_lds((const unsigned*)((const char*)(gbase) + (voff)[_i]), (LAS unsigned*)(lds + (bufoff) + ldsw + _i * 8192), 16, 0, 0); } while (0)
#define PG8_LDA(dst, b, h) do { _Pragma("unroll") for (int m = 0; m < 4; ++m) _Pragma("unroll") for (int k = 0; k < 2; ++k) dst[m][k] = *(const LAS bf16x8*)(lds + PG8_SA(b, h) + aoff + m * 2048 + k * 1024); } while (0)
#define PG8_LDB(dst, b, h) do { _Pragma("unroll") for (int n = 0; n < 2; ++n) _Pragma("unroll") for (int k = 0; k < 2; ++k) dst[n][k] = *(const LAS bf16x8*)(lds + PG8_SB(b, h) + boff + n * 2048 + k * 1024); } while (0)
#define PG8_MMA(ai, bj, At, Bt) do { __builtin_amdgcn_s_setprio(1); _Pragma("unroll") for (int m = 0; m < 4; ++m) _Pragma("unroll") for (int n = 0; n < 2; ++n) _Pragma("unroll") for (int k = 0; k < 2; ++k) \
        acc[ai][bj][m][n] = __builtin_amdgcn_mfma_f32_16x16x32_bf16(Bt[n][k], At[m][k], acc[ai][bj][m][n], 0, 0, 0); __builtin_amdgcn_s_setprio(0); } while (0)
#define PG8_WAIT_V(n) asm volatile("s_waitcnt vmcnt(" #n ")" ::: "memory")
#define PG8_WAIT_L(n) asm volatile("s_waitcnt lgkmcnt(" #n ")" ::: "memory")
#define PG8_BAR __builtin_amdgcn_s_barrier()
#define PG8_SCHED __builtin_amdgcn_sched_barrier(0)
    Unit cur, nxt; int ui = 0;
    if (!S.next(0, cur)) return;
    f32x4 acc[2][2][4][2];
#pragma unroll
    for (int a = 0; a < 2; ++a)
#pragma unroll
        for (int b = 0; b < 2; ++b)
#pragma unroll
            for (int m = 0; m < 4; ++m)
#pragma unroll
                for (int n = 0; n < 2; ++n) acc[a][b][m][n] = (f32x4){0.f, 0.f, 0.f, 0.f};
    bf16x8 At[4][2], B0[2][2], B1[2][2];
#define PG8_ABASE(u) ((const char*)((u).kind == 0 ? g.A : ((u).kind == 1 ? g.A1 : g.A2)) + (size_t)(u).pm * tstepA)
#define PG8_BBASE(u) ((const char*)((u).kind == 0 ? g.Bt : ((u).kind == 1 ? g.Bt1 : g.Bt2)) + (size_t)(u).pn * tstepB)
    const char* cA = PG8_ABASE(cur); const char* cB = PG8_BBASE(cur);
    PG8_STAGE(PG8_SB(0, 0), cB, voffB); PG8_STAGE(PG8_SB(0, 1), cB + hstepB, voffB); PG8_STAGE(PG8_SA(0, 0), cA, voffA); PG8_STAGE(PG8_SA(0, 1), cA + hstepA, voffA);
    if (wr == 1) PG8_BAR;
    PG8_WAIT_V(2); PG8_BAR;
    PG8_STAGE(PG8_SB(1, 0), cB + kstep, voffB); PG8_STAGE(PG8_SA(1, 0), cA + kstep, voffA); PG8_STAGE(PG8_SB(1, 1), cB + hstepB + kstep, voffB);
    PG8_WAIT_V(6); PG8_BAR;
    for (;;) {
        const bool has_next = S.next(ui + 1, nxt);
        const char* nA = has_next ? PG8_ABASE(nxt) : cA; const char* nB = has_next ? PG8_BBASE(nxt) : cB;
        for (int t = 0; t < nt; t += 2) {
            const bool last = (t == nt - 2);
            const char* a1 = cA + (size_t)(t + 1) * kstep;
            const char* a2 = last ? nA : cA + (size_t)(t + 2) * kstep; const char* b2 = last ? nB : cB + (size_t)(t + 2) * kstep;
            const char* a3 = a2 + kstep; const char* b3 = b2 + kstep;
            PG8_LDB(B0, 0, 0); PG8_LDB(B1, 0, 1); PG8_SCHED; PG8_LDA(At, 0, 0); PG8_STAGE(PG8_SA(1, 1), a1 + hstepA, voffA);
            PG8_WAIT_V(8); PG8_WAIT_L(0); PG8_BAR; PG8_MMA(0, 0, At, B0); PG8_MMA(0, 1, At, B1); PG8_BAR; PG8_SCHED;
            PG8_LDA(At, 0, 1); PG8_STAGE(PG8_SB(0, 0), b2, voffB); PG8_STAGE(PG8_SB(0, 1), b2 + hstepB, voffB); PG8_STAGE(PG8_SA(0, 0), a2, voffA);
            PG8_WAIT_V(8); PG8_WAIT_L(0); PG8_BAR; PG8_MMA(1, 0, At, B0); PG8_MMA(1, 1, At, B1); PG8_BAR; PG8_SCHED;
            PG8_LDB(B0, 1, 0); PG8_LDB(B1, 1, 1); PG8_SCHED; PG8_LDA(At, 1, 0); PG8_STAGE(PG8_SA(0, 1), a2 + hstepA, voffA);
            PG8_WAIT_V(8); PG8_WAIT_L(0); PG8_BAR; PG8_MMA(0, 0, At, B0); PG8_MMA(0, 1, At, B1); PG8_BAR; PG8_SCHED;
            PG8_LDA(At, 1, 1); PG8_STAGE(PG8_SB(1, 0), b3, voffB); PG8_STAGE(PG8_SB(1, 1), b3 + hstepB, voffB); PG8_STAGE(PG8_SA(1, 0), a3, voffA);
            PG8_WAIT_V(8); PG8_WAIT_L(0); PG8_BAR; PG8_MMA(1, 0, At, B0); PG8_MMA(1, 1, At, B1); PG8_BAR; PG8_SCHED;
        }
        if (wr == 0) PG8_BAR;
        E(acc, cur, wr, wc, fr, fq);
        if (!has_next) break;
#pragma unroll
        for (int a = 0; a < 2; ++a)
#pragma unroll
            for (int b = 0; b < 2; ++b)
#pragma unroll
                for (int m = 0; m < 4; ++m)
#pragma unroll
                    for (int n = 0; n < 2; ++n) acc[a][b][m][n] = (f32x4){0.f, 0.f, 0.f, 0.f};
        cur = nxt; cA = nA; cB = nB; ++ui;
        if (wr == 1) PG8_BAR;
    }
    PG8_WAIT_V(0);
    PG8_BAR;
#undef PG8_ABASE
#undef PG8_BBASE
#undef PG8_SA
#undef PG8_SB
#undef PG8_STAGE
#undef PG8_LDA
#undef PG8_LDB
#undef PG8_MMA
#undef PG8_WAIT_V
#undef PG8_WAIT_L
#undef PG8_BAR
#undef PG8_SCHED
}
}
using pg8::Unit;
typedef f32x4 AccT[2][2][4][2];

DI void row_to_chunk(int R, int& n, int& tau) {
    if (R < MLAT) { const int b = R >> 12, t = R & 4095; n = b * 272 + 16 + (t >> 4); tau = t & 15; }
    else { const int r2 = R - MLAT, b = r2 >> 8, t = r2 & 255; n = b * 272 + (t >> 4); tau = t & 15; }
}

struct EpiStoreBf16 {
    static constexpr bool PERM = true;
    bf16_t* O; int ldc;
    DI void operator()(const AccT& acc, const Unit& u, int wr, int wc, int fr, int fq) const {
        const int row0 = u.pm * 256 + wr * 64 + fr, col0 = u.pn * 256 + wc * 32 + 8 * fq;
#pragma unroll
        for (int ai = 0; ai < 2; ++ai)
#pragma unroll
            for (int m = 0; m < 4; ++m) { bf16_t* rowp = O + (size_t)(row0 + ai * 128 + m * 16) * ldc + col0;
#pragma unroll
                for (int bj = 0; bj < 2; ++bj) { const f32x4 v0 = acc[ai][bj][m][0], v1 = acc[ai][bj][m][1];
                    u32x4 w; w.x = cvtpk(v0[0], v0[1]); w.y = cvtpk(v0[2], v0[3]); w.z = cvtpk(v1[0], v1[1]); w.w = cvtpk(v1[2], v1[3]);
                    *(u32x4*)(rowp + bj * 128) = w; } }
    }
};
struct EpiProjB {
    static constexpr bool PERM = false;
    bf16_t* A3; bf16_t* SG;
    DI void operator()(const AccT& acc, const Unit& u, int wr, int wc, int fr, int fq) const {
        const bool is_su = u.pn < 4;
#pragma unroll
        for (int ai = 0; ai < 2; ++ai)
#pragma unroll
            for (int m = 0; m < 4; ++m) {
                const int R = u.pm * 256 + ai * 128 + wr * 64 + m * 16 + fr;
                int n, tau; row_to_chunk(R, n, tau);
#pragma unroll
                for (int bj = 0; bj < 2; ++bj)
#pragma unroll
                    for (int nn = 0; nn < 2; ++nn) {
                        const int col = u.pn * 256 + bj * 128 + wc * 32 + nn * 16 + fq * 4;
                        const f32x4 v = acc[ai][bj][m][nn];
                        u32x2 w; w.x = cvtpk(v[0], v[1]); w.y = cvtpk(v[2], v[3]);
                        if (is_su) { const int g = col >> 4, c = col & 15; *(u32x2*)(A3 + ((size_t)(g * 1280 + n) * 512 + tau * 16 + c)) = w; }
                        else { *(u32x2*)(SG + (size_t)R * 1024 + (col - 1024)) = w; }
                    }
            }
    }
};
struct EpiOut0 {
    static constexpr bool PERM = false;
    const float* x; const float* ctx; const float* mod0; float* out; float* ctx1;
    DI void operator()(const AccT& acc, const Unit& u, int wr, int wc, int fr, int fq) const {
        const int R0 = u.pm * 256;
        const bool lat = R0 < MLAT;
        const int mrow = lat ? (R0 >> 12) : 4;
        const float* gate = mod0 + mrow * 6144 + 4096;
        const float* srcb = lat ? x + (size_t)R0 * DM : ctx + (size_t)(R0 - MLAT) * DM;
        float* dstb = lat ? out + (size_t)R0 * DM : ctx1 + (size_t)(R0 - MLAT) * DM;
        const int colb = u.pn * 256 + wc * 32 + fq * 4;
        f32x4 gv[2][2];
#pragma unroll
        for (int bj = 0; bj < 2; ++bj)
#pragma unroll
            for (int nn = 0; nn < 2; ++nn) gv[bj][nn] = *(const f32x4*)(gate + colb + bj * 128 + nn * 16);
#pragma unroll
        for (int ai = 0; ai < 2; ++ai) {
            f32x4 xv[4][2][2];
#pragma unroll
            for (int m = 0; m < 4; ++m)
#pragma unroll
                for (int bj = 0; bj < 2; ++bj)
#pragma unroll
                    for (int nn = 0; nn < 2; ++nn) xv[m][bj][nn] = *(const f32x4*)(srcb + (size_t)(ai * 128 + wr * 64 + m * 16 + fr) * DM + colb + bj * 128 + nn * 16);
#pragma unroll
            for (int m = 0; m < 4; ++m)
#pragma unroll
                for (int bj = 0; bj < 2; ++bj)
#pragma unroll
                    for (int nn = 0; nn < 2; ++nn) *(f32x4*)(dstb + (size_t)(ai * 128 + wr * 64 + m * 16 + fr) * DM + colb + bj * 128 + nn * 16) = xv[m][bj][nn] + gv[bj][nn] * acc[ai][bj][m][nn];
        }
    }
};


struct EpiS5E {
    static constexpr bool PERM = false;
    float* E;
    DI void operator()(const AccT& acc, const Unit& u, int wr, int wc, int fr, int fq) const {
        const int g = u.pn, tile = u.pm - 5 * g;
#pragma unroll
        for (int ai = 0; ai < 2; ++ai)
#pragma unroll
            for (int m = 0; m < 4; ++m) {
                const int n = tile * 256 + ai * 128 + wr * 64 + m * 16 + fr;
                if (n < 1088) {
                    float* rowp = E + (size_t)(g * 1088 + n) * 256;
#pragma unroll
                    for (int bj = 0; bj < 2; ++bj)
#pragma unroll
                        for (int nn = 0; nn < 2; ++nn) *(f32x4*)(rowp + bj * 128 + wc * 32 + nn * 16 + fq * 4) = acc[ai][bj][m][nn];
                }
            }
    }
};
struct EpiS5Y {
    static constexpr bool PERM = false;
    bf16_t* GB;
    DI void operator()(const AccT& acc, const Unit& u, int wr, int wc, int fr, int fq) const {
        const int g = u.pn, tile = u.pm - 5 * g;
#pragma unroll
        for (int ai = 0; ai < 2; ++ai)
#pragma unroll
            for (int m = 0; m < 4; ++m) {
                const int n = tile * 256 + ai * 128 + wr * 64 + m * 16 + fr;
                if (n < 1088) {
                    const int b = n / 272, kc = n - b * 272;
                    const int R0 = kc < 16 ? MLAT + b * 256 + kc * 16 : b * 4096 + (kc - 16) * 16;
#pragma unroll
                    for (int bj = 0; bj < 2; ++bj)
#pragma unroll
                        for (int nn = 0; nn < 2; ++nn) {
                            const int kk = bj * 128 + wc * 32 + nn * 16 + fq * 4, t = kk >> 4, co = kk & 15;
                            const f32x4 v = acc[ai][bj][m][nn];
                            u32x2 w; w.x = cvtpk(gelu_tanh(v[0]), gelu_tanh(v[1])); w.y = cvtpk(gelu_tanh(v[2]), gelu_tanh(v[3]));
                            *(u32x2*)(GB + (size_t)(R0 + t) * 1024 + g * 16 + co) = w;
                        }
                }
            }
    }
};
struct EpiGlu {
    static constexpr bool PERM = false;
    const bf16_t* GB; const bf16_t* SG; const float* bias; bf16_t* MIXED;
    DI void operator()(const AccT& acc, const Unit& u, int wr, int wc, int fr, int fq) const {
        const int colb = u.pn * 256 + wc * 32 + fq * 4;
        f32x4 bv[2][2];
#pragma unroll
        for (int bj = 0; bj < 2; ++bj)
#pragma unroll
            for (int nn = 0; nn < 2; ++nn) bv[bj][nn] = *(const f32x4*)(bias + colb + bj * 128 + nn * 16);
#pragma unroll
        for (int ai = 0; ai < 2; ++ai) {
            u32x2 gw[4][2][2], sw[4][2][2];
#pragma unroll
            for (int m = 0; m < 4; ++m) { const size_t R = (size_t)(u.pm * 256 + ai * 128 + wr * 64 + m * 16 + fr);
#pragma unroll
                for (int bj = 0; bj < 2; ++bj)
#pragma unroll
                    for (int nn = 0; nn < 2; ++nn) { const int col = colb + bj * 128 + nn * 16; gw[m][bj][nn] = *(const u32x2*)(GB + R * 1024 + col); sw[m][bj][nn] = *(const u32x2*)(SG + R * 1024 + col); } }
#pragma unroll
            for (int m = 0; m < 4; ++m) { const size_t R = (size_t)(u.pm * 256 + ai * 128 + wr * 64 + m * 16 + fr);
#pragma unroll
                for (int bj = 0; bj < 2; ++bj)
#pragma unroll
                    for (int nn = 0; nn < 2; ++nn) {
                        const int col = colb + bj * 128 + nn * 16;
                        const f32x4 v = acc[ai][bj][m][nn] + bv[bj][nn];
                        const u32x2 g = gw[m][bj][nn], sg = sw[m][bj][nn];
                        u32x2 w; w.x = cvtpk(bflo(g.x) * sigmoidf_(v[0]) * siluf_(bflo(sg.x)), bfhi(g.x) * sigmoidf_(v[1]) * siluf_(bfhi(sg.x)));
                        w.y = cvtpk(bflo(g.y) * sigmoidf_(v[2]) * siluf_(bflo(sg.y)), bfhi(g.y) * sigmoidf_(v[3]) * siluf_(bfhi(sg.y)));
                        *(u32x2*)(MIXED + R * 2048 + 1024 + col) = w;
                    } }
        }
    }
};

constexpr float QSCALE = 0.125f * 1.4426950408889634f;
constexpr float LAM_INIT = 0.35550906759096335f;
struct QKGOrder {
    pg8::StaticOrder S;
    __device__ bool next(int i, Unit& u) const { if (!S.next(i, u)) return false; if (u.pn >= 16) u.pn += 8; return true; }
};
struct EpiQKG {
    static constexpr bool PERM = true;
    bf16_t* Q; bf16_t* K; bf16_t* GATE; const float* qn; const float* kn; const float* rope; int row_off, pn_off;
    DI void operator()(const AccT& acc, const Unit& u, int wr, int wc, int fr, int fq) const {
        const int pn = u.pn + pn_off;
        if (pn >= 24) {
#pragma unroll
            for (int ai = 0; ai < 2; ++ai)
#pragma unroll
                for (int m = 0; m < 4; ++m) {
                    const int R = row_off + u.pm * 256 + ai * 128 + wr * 64 + m * 16 + fr;
#pragma unroll
                    for (int bj = 0; bj < 2; ++bj) {
                        const int col = (pn - 24) * 256 + bj * 128 + wc * 32 + 8 * fq;
                        const f32x4 v0 = acc[ai][bj][m][0], v1 = acc[ai][bj][m][1];
                        u32x4 w; w.x = cvtpk(siluf_(v0[0]), siluf_(v0[1])); w.y = cvtpk(siluf_(v0[2]), siluf_(v0[3])); w.z = cvtpk(siluf_(v1[0]), siluf_(v1[1])); w.w = cvtpk(siluf_(v1[2]), siluf_(v1[3]));
                        *(u32x4*)(GATE + (size_t)R * 2048 + col) = w;
                    }
                }
            return;
        }
        const bool isq = pn < 8;
        const int hm = 4 * (pn & 7) + wc, h = hm >> 1, mp = hm & 1;
        const float* nw = isq ? qn : kn;
        f32x4 w[2][2];
#pragma unroll
        for (int bj = 0; bj < 2; ++bj)
#pragma unroll
            for (int nn = 0; nn < 2; ++nn) w[bj][nn] = *(const f32x4*)(nw + 32 * bj + 16 * nn + 4 * fq);
#pragma unroll
        for (int ai = 0; ai < 2; ++ai) {
            const bool lat = (row_off + u.pm * 256) < MLAT;
            f32x4 cs[4][2], sn[4][2];
            if (lat) {
#pragma unroll
                for (int m = 0; m < 4; ++m) { const int t = (row_off + u.pm * 256 + ai * 128 + wr * 64 + m * 16 + fr) & 4095;
#pragma unroll
                    for (int bj = 0; bj < 2; ++bj) { const int pos = bj == 0 ? (t >> 6) : (t & 63); cs[m][bj] = *(const f32x4*)(rope + pos * 32 + 4 * fq); sn[m][bj] = *(const f32x4*)(rope + pos * 32 + 16 + 4 * fq); } }
            }
#pragma unroll
            for (int m = 0; m < 4; ++m) {
                const int R = row_off + u.pm * 256 + ai * 128 + wr * 64 + m * 16 + fr;
                float ss = 0.f;
#pragma unroll
                for (int bj = 0; bj < 2; ++bj)
#pragma unroll
                    for (int nn = 0; nn < 2; ++nn) { const f32x4 v = acc[ai][bj][m][nn]; ss += (v[0] * v[0] + v[1] * v[1]) + (v[2] * v[2] + v[3] * v[3]); }
                ss += __shfl_xor(ss, 16); ss += __shfl_xor(ss, 32);
                const float rstd = __builtin_amdgcn_rsqf(ss * (1.0f / 64.0f) + EPS);
                const int b = lat ? (R >> 12) : ((R - MLAT) >> 8);
                const int t = lat ? (R & 4095) : ((R - MLAT) & 255);
                bf16_t* dst = isq ? Q + ((size_t)((b * 16 + h) * 2 + mp) * 4096 + t) * 64
                                  : K + ((size_t)((b * 16 + h) * 2 + mp) * 4352 + (lat ? 256 + t : t)) * 64;
#pragma unroll
                for (int bj = 0; bj < 2; ++bj) {
                    f32x4 x1 = acc[ai][bj][m][0] * rstd * w[bj][0], x2 = acc[ai][bj][m][1] * rstd * w[bj][1];
                    if (lat) { const f32x4 o1 = x1 * cs[m][bj] - x2 * sn[m][bj], o2 = x1 * sn[m][bj] + x2 * cs[m][bj]; x1 = o1; x2 = o2; }
                    if (isq) { x1 = x1 * QSCALE; x2 = x2 * QSCALE; }
                    u32x2 p1, p2; p1.x = cvtpk(x1[0], x1[1]); p1.y = cvtpk(x1[2], x1[3]); p2.x = cvtpk(x2[0], x2[1]); p2.y = cvtpk(x2[2], x2[3]);
                    *(u32x2*)(dst + 32 * bj + 4 * fq) = p1; *(u32x2*)(dst + 32 * bj + 16 + 4 * fq) = p2;
                }
            }
        }
    }
};
struct EpiVT {
    static constexpr bool PERM = true;
    bf16_t* VT;
    DI void operator()(const AccT& acc, const Unit& u, int wr, int wc, int fr, int fq) const {
        const int R0 = u.pn * 256;
        const bool lat = R0 < MLAT;
        const int b = lat ? (R0 >> 12) : ((R0 - MLAT) >> 8);
        const int kv0 = lat ? 256 + (R0 & 4095) : ((R0 - MLAT) & 255);
#pragma unroll
        for (int ai = 0; ai < 2; ++ai)
#pragma unroll
            for (int m = 0; m < 4; ++m) {
                const int vc = u.pm * 256 + ai * 128 + wr * 64 + m * 16 + fr, h = vc >> 7, e = vc & 127;
                bf16_t* rowp = VT + ((size_t)((b * 16 + h) * 128 + e)) * 4352 + kv0 + wc * 32 + 8 * fq;
#pragma unroll
                for (int bj = 0; bj < 2; ++bj) { const f32x4 v0 = acc[ai][bj][m][0], v1 = acc[ai][bj][m][1];
                    u32x4 w; w.x = cvtpk(v0[0], v0[1]); w.y = cvtpk(v0[2], v0[3]); w.z = cvtpk(v1[0], v1[1]); w.w = cvtpk(v1[2], v1[3]);
                    *(u32x4*)(rowp + bj * 128) = w; }
            }
    }
};
struct EpiOut1 {
    static constexpr bool PERM = false;
    const float* mod1; float* out;
    DI void operator()(const AccT& acc, const Unit& u, int wr, int wc, int fr, int fq) const {
        const int R0 = u.pm * 256;
        const float* gate = mod1 + (R0 >> 12) * 6144 + 4096;
        float* dstb = out + (size_t)R0 * DM;
        const int colb = u.pn * 256 + wc * 32 + fq * 4;
        f32x4 gv[2][2];
#pragma unroll
        for (int bj = 0; bj < 2; ++bj)
#pragma unroll
            for (int nn = 0; nn < 2; ++nn) gv[bj][nn] = *(const f32x4*)(gate + colb + bj * 128 + nn * 16);
#pragma unroll
        for (int ai = 0; ai < 2; ++ai) {
            f32x4 xv[4][2][2];
#pragma unroll
            for (int m = 0; m < 4; ++m)
#pragma unroll
                for (int bj = 0; bj < 2; ++bj)
#pragma unroll
                    for (int nn = 0; nn < 2; ++nn) xv[m][bj][nn] = *(const f32x4*)(dstb + (size_t)(ai * 128 + wr * 64 + m * 16 + fr) * DM + colb + bj * 128 + nn * 16);
#pragma unroll
            for (int m = 0; m < 4; ++m)
#pragma unroll
                for (int bj = 0; bj < 2; ++bj)
#pragma unroll
                    for (int nn = 0; nn < 2; ++nn) *(f32x4*)(dstb + (size_t)(ai * 128 + wr * 64 + m * 16 + fr) * DM + colb + bj * 128 + nn * 16) = xv[m][bj][nn] + gv[bj][nn] * acc[ai][bj][m][nn];
        }
    }
};

struct EpiHyT {
    static constexpr bool PERM = false;
    bf16_t* O;
    DI void operator()(const AccT& acc, const Unit& u, int wr, int wc, int fr, int fq) const {
#pragma unroll
        for (int ai = 0; ai < 2; ++ai)
#pragma unroll
            for (int m = 0; m < 4; ++m) { bf16_t* rowp = O + (size_t)(u.pm * 256 + ai * 128 + wr * 64 + m * 16 + fr) * MTOT + u.pn * 256 + wc * 32 + 4 * fq;
#pragma unroll
                for (int bj = 0; bj < 2; ++bj)
#pragma unroll
                    for (int nn = 0; nn < 2; ++nn) { const f32x4 v = acc[ai][bj][m][nn]; u32x2 w; w.x = cvtpk(v[0], v[1]); w.y = cvtpk(v[2], v[3]); *(u32x2*)(rowp + bj * 128 + nn * 16) = w; } }
    }
};

struct EpiProjBP {
    static constexpr bool PERM = true;
    bf16_t* A3; bf16_t* SG;
    DI void operator()(const AccT& acc, const Unit& u, int wr, int wc, int fr, int fq) const {
        const bool is_su = u.pn < 4;
#pragma unroll
        for (int ai = 0; ai < 2; ++ai)
#pragma unroll
            for (int m = 0; m < 4; ++m) {
                const int R = u.pm * 256 + ai * 128 + wr * 64 + m * 16 + fr;
                int n, tau; row_to_chunk(R, n, tau);
#pragma unroll
                for (int bj = 0; bj < 2; ++bj) {
                    const int col = u.pn * 256 + bj * 128 + wc * 32 + 8 * fq;
                    const f32x4 v0 = acc[ai][bj][m][0], v1 = acc[ai][bj][m][1];
                    u32x4 w; w.x = cvtpk(v0[0], v0[1]); w.y = cvtpk(v0[2], v0[3]); w.z = cvtpk(v1[0], v1[1]); w.w = cvtpk(v1[2], v1[3]);
                    if (is_su) { const int g = col >> 4, c = col & 15; *(u32x4*)(A3 + ((size_t)(g * 1280 + n) * 512 + tau * 16 + c)) = w; }
                    else { *(u32x4*)(SG + (size_t)R * 1024 + (col - 1024)) = w; }
                }
            }
    }
};
struct P2Order { pg8::StaticOrder S0, S1; int G, c;
    __device__ bool next(int i, Unit& u) const { const long L = (long)i * G + c; if (L < S0.nwg) return S0.map(L, u); if (!S1.map(L - S0.nwg, u)) return false; u.kind = 1; return true; } };
struct EpiP2 { static constexpr bool PERM = true; EpiStoreBf16 e0; EpiProjBP e1;
    DI void operator()(const AccT& acc, const Unit& u, int wr, int wc, int fr, int fq) const { if (u.kind == 0) e0(acc, u, wr, wc, fr, fq); else e1(acc, u, wr, wc, fr, fq); } };
struct EpiVTn {
    static constexpr bool PERM = false;
    bf16_t* VT;
    DI void operator()(const AccT& acc, const Unit& u, int wr, int wc, int fr, int fq) const {
        const int R0 = u.pn * 256; const bool lat = R0 < MLAT;
        const int b = lat ? (R0 >> 12) : ((R0 - MLAT) >> 8);
        const int kv0 = lat ? 256 + (R0 & 4095) : ((R0 - MLAT) & 255);
#pragma unroll
        for (int ai = 0; ai < 2; ++ai)
#pragma unroll
            for (int m = 0; m < 4; ++m) {
                const int vc = u.pm * 256 + ai * 128 + wr * 64 + m * 16 + fr, h = vc >> 7, e = vc & 127;
                bf16_t* rowp = VT + ((size_t)((b * 16 + h) * 128 + e)) * 4352 + kv0 + wc * 32 + 4 * fq;
#pragma unroll
                for (int bj = 0; bj < 2; ++bj)
#pragma unroll
                    for (int nn = 0; nn < 2; ++nn) { const f32x4 v = acc[ai][bj][m][nn]; u32x2 w; w.x = cvtpk(v[0], v[1]); w.y = cvtpk(v[2], v[3]); *(u32x2*)(rowp + bj * 128 + nn * 16) = w; }
            }
    }
};
struct P7Order { pg8::StaticOrder Sa, Sb, Sc; int G, c;
    __device__ bool next(int i, Unit& u) const { long L = (long)i * G + c;
        if (L < Sa.nwg) { Sa.map(L, u); if (u.pn >= 16) u.pn += 8; return true; } L -= Sa.nwg;
        if (L < Sc.nwg) { Sc.map(L, u); u.kind = 2; return true; } L -= Sc.nwg;
        if (!Sb.map(L, u)) return false; u.kind = 1; return true; } };
struct EpiP7 { static constexpr bool PERM = true; EpiQKG ea; EpiVT ec;
    DI void operator()(const AccT& acc, const Unit& u, int wr, int wc, int fr, int fq) const {
        if (u.kind == 2) { ec(acc, u, wr, wc, fr, fq); return; }
        EpiQKG e = ea; e.row_off = u.kind ? MLAT : 0; e.pn_off = u.kind ? 8 : 0; e(acc, u, wr, wc, fr, fq); } };

template <bool QKPERM>
DI void transpose_item(const float* W, int K, int N, bf16_t* WT, LAS float* scr, int item, int lane) {
    const int nblk = N / 32, kb = item / nblk, nb = item % nblk, k0 = 64 * kb, n0 = 32 * nb;
#pragma unroll
    for (int i = 0; i < 32; ++i) { const int kk = 2 * i + (lane >> 5); scr[kk * 33 + (lane & 31)] = W[(size_t)(k0 + kk) * N + n0 + (lane & 31)]; }
    asm volatile("s_waitcnt lgkmcnt(0)" ::: "memory");
    const int c = lane & 7;
#pragma unroll
    for (int j = 0; j < 4; ++j) { const int n = (lane >> 3) + 8 * j; const LAS float* s = scr + (8 * c) * 33 + n;
        u32x4 o; o.x = cvtpk(s[0 * 33], s[1 * 33]); o.y = cvtpk(s[2 * 33], s[3 * 33]); o.z = cvtpk(s[4 * 33], s[5 * 33]); o.w = cvtpk(s[6 * 33], s[7 * 33]);
        int nr = n0 + n;
        if (QKPERM && nr < 4096) { const int cc = nr & 255, d = cc & 31; nr = (nr & ~255) + 128 * ((cc >> 5) & 1) + 32 * (cc >> 6) + 8 * ((d >> 2) & 3) + 4 * (d >> 4) + (d & 3); }
        *(u32x4*)(WT + (size_t)nr * K + k0 + 8 * c) = o; }
    asm volatile("s_waitcnt lgkmcnt(0)" ::: "memory");
}

struct Args { const float* in[38]; float* out; unsigned char* ws; };

enum { I_X = 0, I_C, I_CTX, I_CCTX, I_MODW, I_MODB, I_NORMW, I_EVIN, I_EVOUT, I_HYCW, I_HYCB, I_HYW1, I_HYB1, I_HYW2, I_HYB2, I_HYW3, I_HYB3, I_HYFREQ, I_HYSKIP,
       I_S5ARE, I_S5AIM, I_S5LOGDT, I_S5BRE, I_S5BIM, I_S5CRE, I_S5CIM, I_S5D, I_GLUW, I_GLUB, I_ODIN, I_ODOUT, I_QNORM, I_KNORM, I_LQ1, I_LK1, I_LQ2, I_LK2, I_SUBLN };

DI void mod_item(const Args& a, float* mod, LAS float* scr, int item, int lane) {
    const int kc = item & 31, cg_ = (item >> 5) % 24, l = item / (32 * 24);
    const float* cv = a.in[I_C]; const float* cc = a.in[I_CCTX];
    for (int e = lane; e < 5 * 64; e += 64) { const int r = e >> 6, k = kc * 64 + (e & 63); const float v = (r < 4) ? cv[r * DM + k] : cc[k]; scr[e] = siluf_(v); }
    asm volatile("s_waitcnt lgkmcnt(0)" ::: "memory");
    const float* W = a.in[I_MODW] + (size_t)l * DM * 6144 + (size_t)(kc * 64) * 6144 + cg_ * 256 + lane * 4;
    f32x4 acc[5];
#pragma unroll
    for (int r = 0; r < 5; ++r) acc[r] = (f32x4){0.f, 0.f, 0.f, 0.f};
#pragma unroll 16
    for (int k = 0; k < 64; ++k) { const f32x4 w = *(const f32x4*)(W + (size_t)k * 6144);
#pragma unroll
        for (int r = 0; r < 5; ++r) acc[r] += w * scr[r * 64 + k]; }
    const int col = cg_ * 256 + lane * 4;
    if (kc == 0) { const f32x4 b = *(const f32x4*)(a.in[I_MODB] + l * 6144 + col);
#pragma unroll
        for (int r = 0; r < 5; ++r) acc[r] += b; }
#pragma unroll
    for (int r = 0; r < 5; ++r)
#pragma unroll
        for (int e = 0; e < 4; ++e) unsafeAtomicAdd(mod + (size_t)(l * 5 + r) * 6144 + col + e, acc[r][e]);
    asm volatile("s_waitcnt lgkmcnt(0)" ::: "memory");
}
DI void h2_item(const Args& a, float* h2buf, LAS float* scr, const LAS float* w2s, int item, int lane) {
    const float* w1 = a.in[I_HYW1]; const float* fr = a.in[I_HYFREQ];
    float w1c[33];
#pragma unroll
    for (int i = 0; i < 33; ++i) w1c[i] = w1[i * 64 + lane];
    const float b1v = a.in[I_HYB1][lane], b2v = a.in[I_HYB2][lane], f0 = fr[lane], f1 = fr[64 + lane];
    const bool isctx = item >= 512; const int n = isctx ? 256 : 4096; const int t0 = (isctx ? item - 512 : item) * 8; const int row0 = (isctx ? 4096 : 0) + t0;
#pragma unroll 1
    for (int q = 0; q < 8; ++q) {
        const float tf = (float)(t0 + q);
        { const int i = lane & 15; const float band = 1e-4f + (float)i * ((15.0f - 1e-4f) / 15.0f); const float ang = (6.283185307179586f / (float)n) * tf * band;
          float fv = (lane < 16) ? cosf(ang) : -sinf(ang); if (lane == 32) fv = tf / (float)n; scr[lane] = fv; }
        asm volatile("s_waitcnt lgkmcnt(0)" ::: "memory");
        float s1 = b1v + scr[32] * w1c[0];
#pragma unroll
        for (int i = 0; i < 32; ++i) s1 += scr[i] * w1c[1 + i];
        const float h1 = sinf(f0 * s1);
        asm volatile("s_waitcnt lgkmcnt(0)" ::: "memory");
        scr[64 + lane] = h1;
        asm volatile("s_waitcnt lgkmcnt(0)" ::: "memory");
        float s2 = b2v;
#pragma unroll
        for (int i = 0; i < 64; ++i) s2 += scr[64 + i] * w2s[i * 64 + lane];
        h2buf[(size_t)(row0 + q) * 64 + lane] = sinf(f1 * s2);
        asm volatile("s_waitcnt lgkmcnt(0)" ::: "memory");
    }
}
DI void filt_item(const Args& a, const float* h2buf, bf16_t* glat, bf16_t* gctx, float* l1buf, int item, int lane) {
    const int lt = item >> 5, cgp = item & 31;
    const bool isctx = lt >= 128; const int lag0 = (isctx ? lt - 128 : lt) * 32, hrow0 = (isctx ? 4096 : 0) + lag0, n = isctx ? 256 : 4096;
    const int i32 = lane & 31, k2 = lane >> 5;
    float bv[32];
    { const float* hrow = h2buf + (size_t)(hrow0 + i32) * 64 + k2 * 32;
#pragma unroll
      for (int q = 0; q < 8; ++q) { const f32x4 v = *(const f32x4*)(hrow + 4 * q); bv[4 * q] = v[0]; bv[4 * q + 1] = v[1]; bv[4 * q + 2] = v[2]; bv[4 * q + 3] = v[3]; } }
    const int t = lag0 + i32; const float tn = (float)t / (float)n;
    const float da = -3.0701134573253944f, db = -15.350567286626972f;
    const int glen = isctx ? GCTX_LEN : GLAT_LEN;
    const float* w3 = a.in[I_HYW3]; const float* b3 = a.in[I_HYB3];
#pragma unroll 1
    for (int ct = 0; ct < 4; ++ct) {
        const int col0 = cgp * 128 + ct * 32;
        const float* wp = w3 + (size_t)(k2 * 32) * 4096 + col0 + i32;
        float av[32];
#pragma unroll
        for (int kk = 0; kk < 32; ++kk) av[kk] = wp[(size_t)kk * 4096];
        float b3v[16];
#pragma unroll
        for (int r = 0; r < 16; ++r) b3v[r] = b3[col0 + (r & 3) + 8 * (r >> 2) + 4 * k2];
        f32x16 acc;
#pragma unroll
        for (int r = 0; r < 16; ++r) acc[r] = 0.f;
#pragma unroll
        for (int kk = 0; kk < 32; ++kk) acc = __builtin_amdgcn_mfma_f32_32x32x2f32(av[kk], bv[kk], acc, 0, 0, 0);
        const int f = col0 >> 11, dir = (col0 >> 10) & 1, ch0 = col0 & 1023;
        bf16_t* gbase = isctx ? gctx + (size_t)(f * 1024 + ch0) * GCTX_LEN : glat + (size_t)(f * 1024 + ch0) * GLAT_LEN;
        const int idx = (dir == 0 ? 4223 - t : 4223 + t) - (isctx ? 3840 : 0);
        const bool store = !(dir == 1 && t == 0);
        float* l1p = l1buf + (size_t)lt * 4096 + col0;
        float vv[16], sm[16];
#pragma unroll
        for (int r = 0; r < 16; ++r) {
            const int cl = (r & 3) + 8 * (r >> 2) + 4 * k2;
            const float delta = fabsf(da + (float)(ch0 + cl) * ((db - da) / 1023.0f));
            vv[r] = (acc[r] + b3v[r]) * __expf(-tn * delta);
            sm[r] = store ? fabsf(vv[r]) : 0.f;
        }
        if (store) {
#pragma unroll
            for (int r = 0; r < 16; ++r) { const int cl = (r & 3) + 8 * (r >> 2) + 4 * k2; gbase[(size_t)cl * glen + idx] = (bf16_t)f2bf(vv[r]); }
        }
#pragma unroll
        for (int o = 1; o < 32; o <<= 1) {
            float tmp[16];
#pragma unroll
            for (int r = 0; r < 16; ++r) tmp[r] = __shfl_xor(sm[r], o);
#pragma unroll
            for (int r = 0; r < 16; ++r) sm[r] += tmp[r];
        }
        if (i32 == 0) {
#pragma unroll
            for (int r = 0; r < 16; ++r) l1p[(r & 3) + 8 * (r >> 2) + 4 * k2] = sm[r];
        }
    }
}
DI void modnorm_row(const float* xrow, const float* nw, const float* shift, const float* scale, bf16_t* orow, int lane) {
    f32x4 v[8], w[8], sh[8], sc[8]; float s = 0.f;
#pragma unroll
    for (int j = 0; j < 4; ++j) { const int col = 512 * j + 8 * lane; v[2 * j] = *(const f32x4*)(xrow + col); v[2 * j + 1] = *(const f32x4*)(xrow + col + 4); }
#pragma unroll
    for (int j = 0; j < 4; ++j) { const int col = 512 * j + 8 * lane;
        w[2 * j] = *(const f32x4*)(nw + col); w[2 * j + 1] = *(const f32x4*)(nw + col + 4); sh[2 * j] = *(const f32x4*)(shift + col); sh[2 * j + 1] = *(const f32x4*)(shift + col + 4);
        sc[2 * j] = *(const f32x4*)(scale + col); sc[2 * j + 1] = *(const f32x4*)(scale + col + 4); }
#pragma unroll
    for (int j = 0; j < 8; ++j) s += (v[j][0] * v[j][0] + v[j][1] * v[j][1]) + (v[j][2] * v[j][2] + v[j][3] * v[j][3]);
    const float rstd = __builtin_amdgcn_rsqf(wave_sum(s) * (1.0f / DM) + EPS);
#pragma unroll
    for (int j = 0; j < 4; ++j) { const int col = 512 * j + 8 * lane;
        const f32x4 y0 = (v[2 * j] * rstd) * w[2 * j] * (sc[2 * j] + 1.0f) + sh[2 * j], y1 = (v[2 * j + 1] * rstd) * w[2 * j + 1] * (sc[2 * j + 1] + 1.0f) + sh[2 * j + 1];
        u32x4 o; o.x = cvtpk(y0[0], y0[1]); o.y = cvtpk(y0[2], y0[3]); o.z = cvtpk(y1[0], y1[1]); o.w = cvtpk(y1[2], y1[3]);
        *(u32x4*)(orow + col) = o; }
}


typedef float cplx __attribute__((ext_vector_type(2)));
#define re x
#define im y
DI cplx cmul(cplx a, cplx b) { return (cplx){a.x * b.x - a.y * b.y, a.x * b.y + a.y * b.x}; }
DI void s5_ops_item(const Args& a, unsigned char* ws, LAS unsigned char* lds, int g) {
    const int tid = tid_opaque();
    LAS cplx* lamP = (LAS cplx*)lds;
    LAS cplx* Bb = (LAS cplx*)(lds + 17408);
    LAS cplx* Cc = (LAS cplx*)(lds + 17408 + 16384);
    LAS float* Kd = (LAS float*)(lds + 17408 + 32768);
    const float* are = a.in[I_S5ARE]; const float* aim = a.in[I_S5AIM]; const float* ldt = a.in[I_S5LOGDT];
    const float* bre = a.in[I_S5BRE]; const float* bim = a.in[I_S5BIM]; const float* cre = a.in[I_S5CRE]; const float* cim = a.in[I_S5CIM];
    __syncthreads();
    for (int e = tid; e < 2 * 17 * 64; e += NTHREADS) { const int dir = e / (17 * 64), dl = (e / 64) % 17, p = e & 63;
        const float dt = expf(ldt[dir * 64 + g]); const float ar = are[(dir * 64 + g) * 64 + p], ai = aim[(dir * 64 + g) * 64 + p];
        const float mag = expf((float)dl * dt * ar); float sn, cs; sincosf((float)dl * dt * ai, &sn, &cs);
        lamP[e] = (cplx){mag * cs, mag * sn}; }
    for (int e = tid; e < 2 * 64 * 16; e += NTHREADS) { const int dir = e / 1024, p = (e >> 4) & 63, c = e & 15;
        const float dt = expf(ldt[dir * 64 + g]); const float ar = are[(dir * 64 + g) * 64 + p], ai = aim[(dir * 64 + g) * 64 + p];
        const float mag = expf(dt * ar); float sn, cs; sincosf(dt * ai, &sn, &cs);
        const cplx lm1 = (cplx){mag * cs - 1.f, mag * sn}; const float den = ar * ar + ai * ai;
        const cplx q = (cplx){(lm1.re * ar + lm1.im * ai) / den, (lm1.im * ar - lm1.re * ai) / den};
        const size_t bi = ((size_t)(dir * 64 + g) * 64 + p) * 16 + c;
        Bb[e] = cmul(q, (cplx){bre[bi], bim[bi]}); }
    for (int e = tid; e < 2 * 16 * 64; e += NTHREADS) { const int dir = e / 1024, c = (e >> 6) & 15, p = e & 63;
        const size_t ci = ((size_t)(dir * 64 + g) * 16 + c) * 64 + p; Cc[e] = (cplx){cre[ci], cim[ci]}; }
    __syncthreads();
    for (int e = tid; e < 2 * 16 * 256; e += NTHREADS) { const int dir = e / 4096, dl = (e >> 8) & 15, co = (e >> 4) & 15, ci = e & 15;
        float acc = 0.f;
        for (int p = 0; p < 64; ++p) { const cplx t = cmul(Cc[(dir * 16 + co) * 64 + p], lamP[(dir * 17 + dl) * 64 + p]); const cplx b = Bb[(dir * 64 + p) * 16 + ci]; acc += t.re * b.re - t.im * b.im; }
        Kd[e] = acc; }
    __syncthreads();
    bf16_t* op3 = (bf16_t*)(ws + WS_OPA3) + (size_t)g * 256 * 512;
    const float* dvec = a.in[I_S5D] + g * 16;
    for (int e = tid; e < 256 * 256; e += NTHREADS) { const int row = e >> 8, kk2 = (e & 255) * 2; const int t = row >> 4, co = row & 15;
        float v[2];
#pragma unroll
        for (int q = 0; q < 2; ++q) { const int kk = kk2 + q; float val;
            if (kk < 256) { const int tau = kk >> 4, ci = kk & 15; val = 0.f;
                if (tau <= t) val += Kd[((0 * 16 + (t - tau)) * 16 + co) * 16 + ci];
                if (tau >= t) val += Kd[((1 * 16 + (tau - t)) * 16 + co) * 16 + ci];
                if (tau == t && co == ci) val += dvec[co]; }
            else { const int dir = (kk - 256) >> 7, part = ((kk - 256) >> 6) & 1, p = kk & 63;
                const cplx w = cmul(Cc[(dir * 16 + co) * 64 + p], lamP[(dir * 17 + (dir == 0 ? t + 1 : 16 - t)) * 64 + p]);
                val = part == 0 ? w.re : -w.im; }
            v[q] = val; }
        *(unsigned*)(op3 + (size_t)row * 512 + kk2) = cvtpk(v[0], v[1]); }
    bf16_t* op1 = (bf16_t*)(ws + WS_OPA1) + (size_t)g * 256 * 256;
    for (int e = tid; e < 256 * 128; e += NTHREADS) { const int row = e >> 7, kk2 = (e & 127) * 2; const int dir = row >> 7, part = (row >> 6) & 1, p = row & 63;
        float v[2];
#pragma unroll
        for (int q = 0; q < 2; ++q) { const int kk = kk2 + q, tau = kk >> 4, ci = kk & 15;
            const cplx w = cmul(lamP[(dir * 17 + (dir == 0 ? 15 - tau : tau)) * 64 + p], Bb[(dir * 64 + p) * 16 + ci]);
            v[q] = part == 0 ? w.re : w.im; }
        *(unsigned*)(op1 + (size_t)row * 256 + kk2) = cvtpk(v[0], v[1]); }
    float* lamL = (float*)(ws + WS_LAML) + (size_t)g * 256;
    for (int e = tid; e < 128; e += NTHREADS) { const int dir = e >> 6, p = e & 63; const cplx l = lamP[(dir * 17 + 16) * 64 + p]; lamL[e * 2] = l.re; lamL[e * 2 + 1] = l.im; }
    __syncthreads();
}
#undef re
#undef im
DI void s5_scan_item(unsigned char* ws, int item, int lane) {
    const int dir = item & 1, g = (item >> 1) & 63, b = item >> 7;
    const float* lamL = (const float*)(ws + WS_LAML) + (size_t)g * 256 + (dir * 64 + lane) * 2;
    const float lr = lamL[0], li = lamL[1];
    const float* E = (const float*)(ws + WS_E) + (size_t)(g * 1088 + b * 272) * 256 + dir * 128 + lane;
    bf16_t* A3 = (bf16_t*)(ws + WS_A3) + (size_t)(g * 1280 + b * 272) * 512 + 256 + dir * 128 + lane;
    float sr = 0.f, si = 0.f;
#pragma unroll 1
    for (int s0 = 0; s0 < 272; s0 += 16) {
        float er[16], ei[16]; int kcs[16];
#pragma unroll
        for (int q = 0; q < 16; ++q) { const int s = s0 + q; const int kc = dir == 0 ? s : (s < 16 ? 15 - s : 287 - s); kcs[q] = kc; er[q] = E[(size_t)kc * 256]; ei[q] = E[(size_t)kc * 256 + 64]; }
#pragma unroll
        for (int q = 0; q < 16; ++q) { bf16_t* o = A3 + (size_t)kcs[q] * 512; o[0] = (bf16_t)f2bf(sr); o[64] = (bf16_t)f2bf(si);
            const float nr = lr * sr - li * si + er[q], ni = lr * si + li * sr + ei[q]; sr = nr; si = ni; }
    }
}

constexpr int HY_UROW = 528;
constexpr int HY_JS = 36;
constexpr int HY_GRAW_OFF = 4 * HY_JS * HY_UROW;
constexpr int HY_WIN_OFF = HY_GRAW_OFF + 16960;
constexpr int HY_GRAW2_OFF = HY_WIN_OFF + 8 * 2 * 1024;
constexpr int HY_LDS = HY_GRAW2_OFF + 16960;
static_assert(HY_LDS + 128 <= LDS_BYTES - 64, "hyena LDS");
DI int crow(int r, int hi) { return (r & 3) + 8 * (r >> 2) + 4 * hi; }

DI void sconv8(const bf16_t* p, int t, int n, float w0, float w1, float w2, float bb, float (&o)[8]) {
    const u32x4 m = *(const u32x4*)p; const float um = t > 0 ? bf2f(p[-1]) : 0.f, up = t + 8 < n ? bf2f(p[8]) : 0.f;
    const float x[10] = {um, bflo(m.x), bfhi(m.x), bflo(m.y), bfhi(m.y), bflo(m.z), bfhi(m.z), bflo(m.w), bfhi(m.w), up};
#pragma unroll
    for (int i = 0; i < 8; ++i) o[i] = w0 * x[i] + w1 * x[i + 1] + w2 * x[i + 2] + bb;
}
template <bool isctx>
DI void hyena_item(const Args& a, unsigned char* ws, LAS unsigned char* lds, int item, bool do_store) {
    const int tid = tid_opaque(), lane = tid & 63, wid = __builtin_amdgcn_readfirstlane(tid >> 6);
    const int c = item & 1023;
    constexpr int NI = isctx ? 1 : 16, n = NI * 256, JJ = HY_JS, NGRP = 4 * n / 8, NITER = (NGRP + NTHREADS - 1) / NTHREADS;
    bf16_t* hpt = (bf16_t*)(ws + WS_HPT);
    const float* cw = a.in[I_HYCW]; const float* cb = a.in[I_HYCB];
    constexpr int rbase = isctx ? MLAT : 0;
    constexpr int goff = isctx ? 3840 : 0, glen = isctx ? GCTX_LEN : GLAT_LEN;
    LAS float* red = (LAS float*)(lds + HY_LDS);
    {
        const float* l1part = (const float*)(ws + WS_L1P) + (size_t)(isctx ? 128 : 0) * 4096;
        constexpr int NLT = isctx ? 8 : 128; const int lt_ = tid >> 1, dir_ = tid & 1;
        float v0_ = 0.f, v1_ = 0.f;
        if (lt_ < NLT) { v0_ = l1part[(size_t)lt_ * 4096 + dir_ * 1024 + c]; v1_ = l1part[(size_t)lt_ * 4096 + 2048 + dir_ * 1024 + c]; }
        u32x4 gq[2][3];
#pragma unroll
        for (int f = 0; f < 2; ++f) { const bf16_t* Gsrc = isctx ? (const bf16_t*)(ws + WS_GCTX) + (size_t)(f * 1024 + c) * GCTX_LEN : (const bf16_t*)(ws + WS_GLAT) + (size_t)(f * 1024 + c) * GLAT_LEN;
#pragma unroll
            for (int it = 0; it < (isctx ? 1 : 3); ++it) { const int p = tid + it * NTHREADS; if (p < glen / 8) gq[f][it] = *(const u32x4*)(Gsrc + 8 * p); } }
        { constexpr int RW = HY_UROW / 4, NPR = JJ - NI;
          for (int e = tid; e < 4 * NPR * RW; e += NTHREADS) { const int r = e / RW, w_ = e - r * RW, bb_ = r / NPR, pr = r - bb_ * NPR, jj = pr < 7 ? pr : pr + NI;
              ((LAS unsigned*)lds)[(bb_ * JJ + jj) * RW + w_] = 0u; } }
#pragma unroll
        for (int f = 0; f < 2; ++f)
#pragma unroll
            for (int it = 0; it < (isctx ? 1 : 3); ++it) { const int p = tid + it * NTHREADS; if (p < glen / 8) *(LAS u32x4*)(lds + (f == 0 ? HY_GRAW_OFF : HY_GRAW2_OFF) + 16 * p) = gq[f][it]; }
        v0_ = wave_sum(v0_); v1_ = wave_sum(v1_);
        if (lane == 0) { red[wid] = v0_; red[8 + wid] = v1_; }
    }
    __syncthreads();
    {
        const float w0 = cw[c], w1 = cw[3072 + c], w2 = cw[6144 + c], bb = cb[c];
        const bf16_t* src = hpt + (size_t)c * MTOT + rbase;
#pragma unroll
        for (int it = 0; it < NITER; ++it) { const int e = tid + it * NTHREADS;
            if (e < NGRP) { const int b = e / (n >> 3), t = 8 * (e % (n >> 3)); float o[8]; sconv8(src + b * n + t, t, n, w0, w1, w2, bb, o);
                u32x4 w; w.x = cvtpk(o[0], o[1]); w.y = cvtpk(o[2], o[3]); w.z = cvtpk(o[4], o[5]); w.w = cvtpk(o[6], o[7]);
                *(LAS u32x4*)(lds + (b * JJ + (t >> 8) + 7) * HY_UROW + (t & 255) * 2) = w; } }
    }
    __syncthreads();
    const int ip = lane & 31, hi = lane >> 5, rho = wid;
    LAS unsigned char* win = lds + HY_WIN_OFF + wid * 2048;
    const float* skip = a.in[I_HYSKIP];
    const bf16_t* sgate = hpt + (size_t)(3072 + c) * MTOT + rbase;
    const int il = ip >> 2, bt = ip & 3;
#pragma unroll 1
    for (int f = 0; f < 2; ++f) {
        const int graw = f == 0 ? HY_GRAW_OFF : HY_GRAW2_OFF;
        f32x16 acc0, acc1;
#pragma unroll
        for (int r = 0; r < 16; ++r) { acc0[r] = 0.f; acc1[r] = 0.f; }
        const int sodd = (3975 - rho - goff) & 1;
        unsigned wd[5];
#define HY_LOADW(d_) do { const int base_ = 3975 - 256 * (d_) - rho - goff; const LAS unsigned* gp_ = (const LAS unsigned*)(lds + graw) + ((base_ - sodd) >> 1) + 4 * lane; \
            wd[0] = gp_[0]; wd[1] = gp_[1]; wd[2] = gp_[2]; wd[3] = gp_[3]; wd[4] = gp_[4]; } while (0)
#define HY_STOREW(buf_) do { u32x4 w_; if (sodd) { w_.x = __builtin_amdgcn_alignbit(wd[1], wd[0], 16); w_.y = __builtin_amdgcn_alignbit(wd[2], wd[1], 16); w_.z = __builtin_amdgcn_alignbit(wd[3], wd[2], 16); w_.w = __builtin_amdgcn_alignbit(wd[4], wd[3], 16); } \
            else { w_.x = wd[0]; w_.y = wd[1]; w_.z = wd[2]; w_.w = wd[3]; } *(LAS u32x4*)(win + (buf_) * 1024 + 16 * lane) = w_; } while (0)
        int buf = 0;
        HY_LOADW(-(NI - 1)); HY_STOREW(0);
#pragma unroll 1
        for (int d = -(NI - 1); d <= NI - 1; ++d) {
            if (d < NI - 1) HY_LOADW(d + 1);
            const LAS unsigned char* wb = win + buf * 1024 + 2 * (248 - 8 * ip + 8 * hi);
            const bool val0 = (7 - d >= 0) && (0 - d <= NI - 1);
            const bool val1 = (NI > 8) && (15 - d >= 0) && (8 - d <= NI - 1);
            const LAS unsigned char* ub0 = lds + (bt * JJ + (il - d + 7)) * HY_UROW + 16 * hi;
            const LAS unsigned char* ub1 = ub0 + 8 * HY_UROW;
#pragma unroll
            for (int kh = 0; kh < 2; ++kh) {
                bf16x8 af[8], b0[8], b1[8];
#pragma unroll
                for (int k = 0; k < 8; ++k) af[k] = *(const LAS bf16x8*)(wb + 32 * (8 * kh + k));
                if (val0) {
#pragma unroll
                    for (int k = 0; k < 8; ++k) b0[k] = *(const LAS bf16x8*)(ub0 + 32 * (8 * kh + k));
                }
                if (val1) {
#pragma unroll
                    for (int k = 0; k < 8; ++k) b1[k] = *(const LAS bf16x8*)(ub1 + 32 * (8 * kh + k));
                }
                __builtin_amdgcn_sched_barrier(0);
                if (val0) {
#pragma unroll
                    for (int k = 0; k < 8; ++k) acc0 = __builtin_amdgcn_mfma_f32_32x32x16_bf16(af[k], b0[k], acc0, 0, 0, 0);
                }
                if (val1) {
#pragma unroll
                    for (int k = 0; k < 8; ++k) acc1 = __builtin_amdgcn_mfma_f32_32x32x16_bf16(af[k], b1[k], acc1, 0, 0, 0);
                }
                __builtin_amdgcn_sched_barrier(0);
            }
            if (d < NI - 1) HY_STOREW(buf ^ 1);
            buf ^= 1;
        }
#undef HY_LOADW
#undef HY_STOREW
        __syncthreads();
        const LAS float* rf = red + 8 * f;
        const float inv_l1 = 1.0f / (((rf[0] + rf[1]) + (rf[2] + rf[3])) + ((rf[4] + rf[5]) + (rf[6] + rf[7])));
        const float sk = skip[f * 1024 + c];
#pragma unroll
        for (int ib = 0; ib < 2; ++ib) {
            const int i = 8 * ib + il;
            if (i < NI) {
#pragma unroll
                for (int r = 0; r < 16; ++r) {
                    const int aa = 8 * crow(r, hi) + rho;
                    LAS bf16_t* up = (LAS bf16_t*)(lds + (bt * JJ + i + 7) * HY_UROW + aa * 2);
                    const float av = ib == 0 ? acc0[r] : acc1[r];
                    *up = (bf16_t)f2bf(av * inv_l1 + sk * bf2f(*up));
                }
            }
        }
        __syncthreads();
        {
            const int pc = (f + 1) * 1024 + c;
            const float w0 = cw[pc], w1 = cw[3072 + pc], w2 = cw[6144 + pc], bb = cb[pc];
            const bf16_t* xsrc = hpt + (size_t)pc * MTOT + rbase;
            bf16_t* ydst = hpt + (size_t)c * MTOT + rbase;
#pragma unroll
            for (int it = 0; it < NITER; ++it) { const int e = tid + it * NTHREADS;
                if (e < NGRP) { const int b = e / (n >> 3), t = 8 * (e % (n >> 3)); float o[8]; sconv8(xsrc + b * n + t, t, n, w0, w1, w2, bb, o);
                    LAS u32x4* up = (LAS u32x4*)(lds + (b * JJ + (t >> 8) + 7) * HY_UROW + (t & 255) * 2);
                    const u32x4 uw = *up;
                    const float z[8] = {o[0] * bflo(uw.x), o[1] * bfhi(uw.x), o[2] * bflo(uw.y), o[3] * bfhi(uw.y), o[4] * bflo(uw.z), o[5] * bfhi(uw.z), o[6] * bflo(uw.w), o[7] * bfhi(uw.w)};
                    if (f == 0) { u32x4 w; w.x = cvtpk(z[0], z[1]); w.y = cvtpk(z[2], z[3]); w.z = cvtpk(z[4], z[5]); w.w = cvtpk(z[6], z[7]); *up = w; }
                    else { const u32x4 hw = *(const u32x4*)(sgate + b * n + t); u32x4 w;
                        w.x = cvtpk(z[0] * siluf_(bflo(hw.x)), z[1] * siluf_(bfhi(hw.x))); w.y = cvtpk(z[2] * siluf_(bflo(hw.y)), z[3] * siluf_(bfhi(hw.y)));
                        w.z = cvtpk(z[4] * siluf_(bflo(hw.z)), z[5] * siluf_(bfhi(hw.z))); w.w = cvtpk(z[6] * siluf_(bflo(hw.w)), z[7] * siluf_(bfhi(hw.w)));
                        if (do_store) *(u32x4*)(ydst + b * n + t) = w; } } }
        }
        __syncthreads();
    }
}
DI void hy_transpose_item(unsigned char* ws, LAS unsigned char* scr, int item, int lane) {
    const int ct = item & 15, rt = item >> 4, c0 = ct * 64, R0 = rt * 64;
    const bf16_t* hpt = (const bf16_t*)(ws + WS_HPT); bf16_t* mixed = (bf16_t*)(ws + WS_MIXED);
    const int pc = lane & 7, rg = lane >> 3;
#pragma unroll
    for (int j = 0; j < 8; ++j) { const int row = 8 * j + rg; *(LAS u32x4*)(scr + row * 144 + pc * 16) = *(const u32x4*)(hpt + (size_t)(c0 + row) * MTOT + R0 + 8 * pc); }
    asm volatile("s_waitcnt lgkmcnt(0)" ::: "memory");
#pragma unroll
    for (int j = 0; j < 8; ++j) { const int R = 8 * j + rg;
        unsigned short v[8];
#pragma unroll
        for (int i = 0; i < 8; ++i) v[i] = *(const LAS unsigned short*)(scr + (8 * pc + i) * 144 + R * 2);
        u32x4 w; w.x = (unsigned)v[0] | ((unsigned)v[1] << 16); w.y = (unsigned)v[2] | ((unsigned)v[3] << 16); w.z = (unsigned)v[4] | ((unsigned)v[5] << 16); w.w = (unsigned)v[6] | ((unsigned)v[7] << 16);
        *(u32x4*)(mixed + (size_t)(R0 + R) * 2048 + c0 + 8 * pc) = w; }
    asm volatile("s_waitcnt lgkmcnt(0)" ::: "memory");
}

constexpr int AT_ROWB = 144;
constexpr int AT_KOFF = 0, AT_VOFF = 2 * 64 * AT_ROWB, AT_BUF = AT_VOFF + 128 * AT_ROWB;
constexpr int AT_LOFF = 3 * AT_BUF;
constexpr int NKV = 4352, NKT = NKV / 64;
DI void attn_unit(unsigned char* ws, LAS unsigned char* lds, int b, int h, int qb, float lam, const float* subln) {
    const int tid = tid_opaque(), lane = tid & 63, wid = __builtin_amdgcn_readfirstlane(tid >> 6);
    const int mp = wid >> 2, wq = wid & 3, i32 = lane & 31, hi = lane >> 5;
    const bf16_t* Qg = (const bf16_t*)(ws + WS_Q) + ((size_t)((b * 16 + h) * 2 + mp) * 4096 + qb * 128 + wq * 32) * 64;
    const bf16_t* Kg = (const bf16_t*)(ws + WS_K) + (size_t)((b * 16 + h) * 2) * NKV * 64;
    const bf16_t* Vg = (const bf16_t*)(ws + WS_VT) + (size_t)((b * 16 + h) * 128) * NKV;
    bf16x8 qf[4];
#pragma unroll
    for (int d0 = 0; d0 < 4; ++d0) qf[d0] = *(const bf16x8*)(Qg + i32 * 64 + d0 * 16 + hi * 8);
    const bf16_t* ksrc[2]; const bf16_t* vsrc[2]; int kdst[2], vdst[2];
#pragma unroll
    for (int j = 0; j < 2; ++j) { const int idx = tid + 512 * j;
        const int mm = idx >> 9, row = (idx >> 3) & 63, pc = idx & 7;
        ksrc[j] = Kg + ((size_t)mm * NKV + row) * 64 + pc * 8; kdst[j] = AT_KOFF + mm * 64 * AT_ROWB + row * AT_ROWB + pc * 16;
        const int e = idx >> 3;
        vsrc[j] = Vg + (size_t)e * NKV + pc * 8; vdst[j] = AT_VOFF + e * AT_ROWB + pc * 16; }
    u32x4 kr[2], vr[2];
#pragma unroll
    for (int j = 0; j < 2; ++j) { kr[j] = *(const u32x4*)ksrc[j]; vr[j] = *(const u32x4*)vsrc[j]; }
#pragma unroll
    for (int j = 0; j < 2; ++j) { *(LAS u32x4*)(lds + kdst[j]) = kr[j]; *(LAS u32x4*)(lds + vdst[j]) = vr[j]; }
#pragma unroll
    for (int j = 0; j < 2; ++j) { kr[j] = *(const u32x4*)(ksrc[j] + (size_t)64 * 64); vr[j] = *(const u32x4*)(vsrc[j] + 64); }
#pragma unroll
    for (int j = 0; j < 2; ++j) { *(LAS u32x4*)(lds + AT_BUF + kdst[j]) = kr[j]; *(LAS u32x4*)(lds + AT_BUF + vdst[j]) = vr[j]; }
    __syncthreads();
    const int pi = (i32 & 0x13) | ((i32 & 8) >> 1) | ((i32 & 4) << 1);
    const int koff = AT_KOFF + mp * 64 * AT_ROWB + pi * AT_ROWB + hi * 16;
    const int voff = AT_VOFF + i32 * AT_ROWB + hi * 16;
    f32x16 o[4];
#pragma unroll
    for (int d = 0; d < 4; ++d)
#pragma unroll
        for (int r = 0; r < 16; ++r) o[d][r] = 0.f;
    f32x16 pA[2], pB[2];
    f32x2_t ls2 = {0.f, 0.f};
    const f32x16 zero16 = {0.f, 0.f, 0.f, 0.f, 0.f, 0.f, 0.f, 0.f, 0.f, 0.f, 0.f, 0.f, 0.f, 0.f, 0.f, 0.f};
#define AT_QK(P, bufoff) do { _Pragma("unroll") for (int half = 0; half < 2; ++half) { \
        _Pragma("unroll") for (int d0 = 0; d0 < 4; ++d0) { const bf16x8 kf = *(const LAS bf16x8*)(lds + (bufoff) + koff + half * 32 * AT_ROWB + d0 * 32); \
            P[half] = __builtin_amdgcn_mfma_f32_32x32x16_bf16(kf, qf[d0], d0 == 0 ? zero16 : P[half], 0, 0, 0); } } } while (0)
#define AT_EXPH(PC, half, pa) do { \
            _Pragma("unroll") for (int r = 0; r < 16; r += 2) { PC[half][r] = __builtin_amdgcn_exp2f(PC[half][r]); PC[half][r + 1] = __builtin_amdgcn_exp2f(PC[half][r + 1]); ls2 += (f32x2_t){PC[half][r], PC[half][r + 1]}; } \
            _Pragma("unroll") for (int ks = 0; ks < 2; ++ks) { u32x4 w; w.x = cvtpk(PC[half][8 * ks], PC[half][8 * ks + 1]); w.y = cvtpk(PC[half][8 * ks + 2], PC[half][8 * ks + 3]); \
                w.z = cvtpk(PC[half][8 * ks + 4], PC[half][8 * ks + 5]); w.w = cvtpk(PC[half][8 * ks + 6], PC[half][8 * ks + 7]); pa[ks] = __builtin_bit_cast(bf16x8, w); } } while (0)
#define AT_STEP(PC, PN, t) do { \
        if ((t) + 2 < NKT) { _Pragma("unroll") for (int j = 0; j < 2; ++j) { kr[j] = *(const u32x4*)(ksrc[j] + (size_t)((t) + 2) * 64 * 64); vr[j] = *(const u32x4*)(vsrc[j] + ((t) + 2) * 64); } } \
        bf16x8 kfr[8], pa0[2], pa1[2]; \
        _Pragma("unroll") for (int q = 0; q < 8; ++q) kfr[q] = *(const LAS bf16x8*)(lds + bn + koff + (q >> 2) * 32 * AT_ROWB + (q & 3) * 32); \
        __builtin_amdgcn_sched_barrier(0); \
        AT_EXPH(PC, 0, pa0); \
        if ((t) + 1 < NKT) { _Pragma("unroll") for (int q = 0; q < 8; ++q) PN[q >> 2] = __builtin_amdgcn_mfma_f32_32x32x16_bf16(kfr[q], qf[q & 3], (q & 3) == 0 ? zero16 : PN[q >> 2], 0, 0, 0); } \
        _Pragma("unroll") for (int q = 0; q < 8; ++q) { const bf16x8 vf_ = *(const LAS bf16x8*)(lds + bc + voff + (q >> 1) * 32 * AT_ROWB + (q & 1) * 32); o[q >> 1] = __builtin_amdgcn_mfma_f32_32x32x16_bf16(pa0[q & 1], vf_, o[q >> 1], 0, 0, 0); } \
        AT_EXPH(PC, 1, pa1); \
        _Pragma("unroll") for (int q = 0; q < 8; ++q) { const bf16x8 vf_ = *(const LAS bf16x8*)(lds + bc + voff + (q >> 1) * 32 * AT_ROWB + 64 + (q & 1) * 32); o[q >> 1] = __builtin_amdgcn_mfma_f32_32x32x16_bf16(pa1[q & 1], vf_, o[q >> 1], 0, 0, 0); } \
        if ((t) + 2 < NKT) { _Pragma("unroll") for (int j = 0; j < 2; ++j) { *(LAS u32x4*)(lds + bw + kdst[j]) = kr[j]; *(LAS u32x4*)(lds + bw + vdst[j]) = vr[j]; } } \
        __syncthreads(); \
        { const int tmp_ = bc; bc = bn; bn = bw; bw = tmp_; } } while (0)
    int bc = 0, bn = AT_BUF, bw = 2 * AT_BUF;
    AT_QK(pA, 0);
#pragma unroll 1
    for (int t = 0; t < NKT; t += 2) {
        AT_STEP(pA, pB, t);
        AT_STEP(pB, pA, t + 1);
    }
    const float lsum0 = ls2[0] + ls2[1];
    float lsum = lsum0;
#undef AT_QK
#undef AT_STEP
#undef AT_EXPH
    lsum += __shfl_xor(lsum, 32);
    LAS float* ls = (LAS float*)(lds + AT_LOFF) + wid * 32;
    if (hi == 0) ls[i32] = 1.0f / lsum;
    asm volatile("s_waitcnt lgkmcnt(0)" ::: "memory");
    float rl[16];
#pragma unroll
    for (int r = 0; r < 16; ++r) rl[r] = ls[crow(r, hi)];
    LAS float* X = (LAS float*)lds + wq * 32 * 128;
    if (mp == 1) {
#pragma unroll
        for (int db = 0; db < 4; ++db)
#pragma unroll
            for (int r = 0; r < 16; ++r) X[crow(r, hi) * 128 + db * 32 + i32] = o[db][r] * rl[r] * lam;
    }
    __syncthreads();
    if (mp == 0) {
        float ss[16];
#pragma unroll
        for (int r = 0; r < 16; ++r) { float acc = 0.f;
#pragma unroll
            for (int db = 0; db < 4; ++db) { const float v = o[db][r] * rl[r] - X[crow(r, hi) * 128 + db * 32 + i32]; o[db][r] = v; acc += v * v; }
            ss[r] = acc; }
#pragma unroll
        for (int r = 0; r < 16; ++r) {
#pragma unroll
            for (int off = 1; off < 32; off <<= 1) ss[r] += __shfl_xor(ss[r], off);
            ss[r] = (1.0f - LAM_INIT) / sqrtf(ss[r] * (1.0f / 128.0f) + EPS); }
        const bf16_t* gate = (const bf16_t*)(ws + WS_GATE1); bf16_t* AO = (bf16_t*)(ws + WS_AO);
        const size_t ibase = ((size_t)b * 4096 + qb * 128 + wq * 32) * 2048 + h * 128 + i32;
        bf16_t gvv[4][16];
#pragma unroll
        for (int db = 0; db < 4; ++db)
#pragma unroll
            for (int r = 0; r < 16; ++r) gvv[db][r] = gate[ibase + (size_t)crow(r, hi) * 2048 + db * 32];
#pragma unroll
        for (int db = 0; db < 4; ++db) { const float sw = subln[db * 32 + i32];
#pragma unroll
            for (int r = 0; r < 16; ++r) AO[ibase + (size_t)crow(r, hi) * 2048 + db * 32] = (bf16_t)f2bf(o[db][r] * ss[r] * sw * bf2f(gvv[db][r])); }
    }
    __syncthreads();
}

#define XB_TMO      128
#define XB_XCNT(j)  (256  + 64 * (j))
#define XB_XSUB(j)  (1280 + 64 * (j))
#define XB_XGEN(j)  (2304 + 64 * (j))
#define XB_TOP      3328
#define XB_TOPGEN   3392
#define XCD_BAR_WORDS 3456
#define XB_SPIN_CAP (1u << 22)
DI unsigned xb_ld(unsigned* p)              { return __hip_atomic_load(p, __ATOMIC_RELAXED, __HIP_MEMORY_SCOPE_AGENT); }
DI unsigned xb_add(unsigned* p, unsigned v) { return __hip_atomic_fetch_add(p, v, __ATOMIC_RELAXED, __HIP_MEMORY_SCOPE_AGENT); }
DI unsigned xb_xcc_id() { return (unsigned)__builtin_amdgcn_s_getreg((3 << 11) | 20) & 0xFu; }
#define XB_SPIN(cond, bar) do { unsigned _sp = 0; while (cond) { __builtin_amdgcn_s_sleep(1); \
    if ((++_sp & 255u) == 0u) { if (xb_ld(&(bar)[XB_TMO])) break; if (_sp > XB_SPIN_CAP) { atomicAdd(&(bar)[XB_TMO], 1u); break; } } } } while (0)
struct XcdBarrier { unsigned* bar; unsigned x; volatile LAS unsigned* st; };
DI XcdBarrier xcd_barrier_post(unsigned* bar, volatile LAS unsigned* st) {
    XcdBarrier b; b.bar = bar; b.x = xb_xcc_id(); b.st = st;
    if (threadIdx.x == 0) (void)xb_add(&bar[XB_XCNT(b.x)], 1u);
    return b;
}
DI void xcd_barrier_complete(unsigned* bar, unsigned x, unsigned& nloc, unsigned& nx) {
    const unsigned G = gridDim.x * gridDim.y * gridDim.z;
    unsigned sum, cnt, mine, sp = 0u;
    for (;;) {
        sum = 0u; cnt = 0u; mine = 0u;
#pragma unroll
        for (unsigned j = 0; j < 16; ++j) { const unsigned c = xb_ld(&bar[XB_XCNT(j)]); sum += c; cnt += (c > 0u) ? 1u : 0u; mine = (j == x) ? c : mine; }
        if (sum == G) break;
        __builtin_amdgcn_s_sleep(1);
        if ((++sp & 255u) == 0u) { if (xb_ld(&bar[XB_TMO])) break; if (sp > XB_SPIN_CAP) { atomicAdd(&bar[XB_TMO], 1u); break; } }
    }
    nloc = mine > 0u ? mine : 1u; nx = cnt > 0u ? cnt : 1u;
}
DI void xcd_barrier(const XcdBarrier& b) {
    asm volatile("s_waitcnt vmcnt(0)" ::: "memory");
    __syncthreads();
    if (threadIdx.x == 0) {
        unsigned* bar = b.bar;
        __builtin_amdgcn_s_waitcnt(0);
        unsigned nloc = b.st[0], nx = b.st[1];
        if (nloc == 0u) { xcd_barrier_complete(bar, b.x, nloc, nx); b.st[0] = nloc; b.st[1] = nx; }
        const unsigned old = xb_add(&bar[XB_XSUB(b.x)], 1u);
        const unsigned gen = old / nloc;
        if (old + 1u == (gen + 1u) * nloc) {
            __builtin_amdgcn_fence(__ATOMIC_RELEASE, "agent");
            asm volatile("s_waitcnt vmcnt(0)" ::: "memory");
            const unsigned og = xb_add(&bar[XB_TOP], 1u);
            const unsigned tg = og / nx;
            if (og + 1u == (tg + 1u) * nx) xb_add(&bar[XB_TOPGEN], 1u);
            else XB_SPIN(xb_ld(&bar[XB_TOPGEN]) == tg, bar);
            __builtin_amdgcn_fence(__ATOMIC_ACQUIRE, "agent");
            xb_add(&bar[XB_XGEN(b.x)], 1u);
            asm volatile("s_waitcnt vmcnt(0)" ::: "memory");
        } else {
            XB_SPIN(xb_ld(&bar[XB_XGEN(b.x)]) == gen, bar);
            __builtin_amdgcn_fence(__ATOMIC_ACQUIRE, "agent");
            asm volatile("s_waitcnt vmcnt(0)" ::: "memory");
        }
    }
    __syncthreads();
}

__global__ void __launch_bounds__(NTHREADS, 2) fwd_kernel(Args a) {
    extern __shared__ __attribute__((aligned(16))) unsigned char lds_raw[];
    LAS unsigned char* lds = (LAS unsigned char*)lds_raw;
    cg::grid_group grid = cg::this_grid();
    const int G = gridDim.x, bid = blockIdx.x;
#define PHASE_IDS const int tid = tid_opaque(), lane = tid & 63, wid = __builtin_amdgcn_readfirstlane(tid >> 6), gw = bid * NWAVES + wid, NGW = G * NWAVES; (void)tid; (void)lane; (void)gw; (void)NGW;
    unsigned char* ws = a.ws;
    volatile LAS unsigned* bst = (volatile LAS unsigned*)(lds + LDS_BYTES - 64);
    if (threadIdx.x < 16) bst[threadIdx.x] = 0u;
    __syncthreads();
    const XcdBarrier xbar = xcd_barrier_post((unsigned*)(ws + OFF_BAR), bst);
#define GRID_BAR() xcd_barrier(xbar)
    float* mod = (float*)(ws + OFF_MOD);
    bf16_t* HN = (bf16_t*)(ws + WS_HN);

#ifndef SKIP_P0
    for (int g = G - 1 - bid; g < 64; g += G) s5_ops_item(a, ws, lds, g);
    __syncthreads();
    {
        PHASE_IDS
        LAS float* scr = (LAS float*)(lds + wid * 8704);
        LAS float* w2s = (LAS float*)(lds + 69632);
        { const float* w2 = a.in[I_HYW2]; for (int e = tid; e < 4096; e += NTHREADS) w2s[e] = w2[e]; }
        __syncthreads();
        constexpr int I_A = (2048 / 64) * (6144 / 32), I_B = (2048 / 64) * (2048 / 32), I_C2 = (1024 / 64) * (1024 / 32), I_M = 2 * 24 * 32, I_H = 544;
                if (gw == NGW - 1) { float* rp = (float*)(ws + WS_ROPE); for (int e = lane; e < 1024; e += 64) { const int pos = e >> 4, i = e & 15; const float fr_ = expf(-(float)i * (9.210340371976184f / 16.0f)); float sn, cs; sincosf((float)pos * fr_, &sn, &cs); rp[pos * 32 + i] = cs; rp[pos * 32 + 16 + i] = sn; } }
        for (int it = gw; it < I_M; it += NGW) mod_item(a, mod, scr, it, lane);
        for (int it = gw; it < I_H; it += NGW) h2_item(a, (float*)(ws + WS_H2), scr, w2s, I_H - 1 - it, lane);
        constexpr int NTR = I_A + I_B + I_C2;
        const int NTW = (G > 128 ? G - 64 : G) * NWAVES;
        for (int it = gw; it < NTR && gw < NTW; it += NTW) {
            int r = it;
            if (r < I_A) { transpose_item<false>(a.in[I_EVIN], 2048, 6144, (bf16_t*)(ws + WS_EVIN_T), scr, r, lane); continue; } r -= I_A;
            if (r < I_B) { transpose_item<false>(a.in[I_EVOUT], 2048, 2048, (bf16_t*)(ws + WS_EVOUT_T), scr, r, lane); continue; } r -= I_B;
            transpose_item<false>(a.in[I_GLUW], 1024, 1024, (bf16_t*)(ws + WS_GLU_T), scr, r, lane);
        }

    }
#endif
    grid.sync();
#ifndef SKIP_P1
    {
        PHASE_IDS
        {
            bf16_t* glat = (bf16_t*)(ws + WS_GLAT); bf16_t* gctx = (bf16_t*)(ws + WS_GCTX);
            const int gt = bid * NTHREADS + tid, GT = G * NTHREADS;
            for (int e = gt; e < 2048 * 258; e += GT) { const int fc = e / 258, q = e % 258; const int idx = q < 128 ? q : 8319 + (q - 128); if (idx < GLAT_LEN) glat[(size_t)fc * GLAT_LEN + idx] = 0; }
            for (int e = gt; e < 2048 * 258; e += GT) { const int fc = e / 258, q = e % 258; const int idx = q < 128 ? q : 639 + (q - 128); if (idx < GCTX_LEN) gctx[(size_t)fc * GCTX_LEN + idx] = 0; }
        }
        constexpr int NF = 136 * 32;
        for (int it = gw; it < NF; it += NGW) filt_item(a, (const float*)(ws + WS_H2), (bf16_t*)(ws + WS_GLAT), (bf16_t*)(ws + WS_GCTX), (float*)(ws + WS_L1P), it, lane);
        const float* nw = a.in[I_NORMW];
        for (int rep = 0; rep < REP_P1M; ++rep)
        for (int R = gw; R < MTOT; R += NGW) {
            const bool lat = R < MLAT; const int mrow = lat ? (R >> 12) : 4;
            const float* xr = lat ? a.in[I_X] + (size_t)R * DM : a.in[I_CTX] + (size_t)(R - MLAT) * DM;
            modnorm_row(xr, nw, mod + mrow * 6144, mod + mrow * 6144 + 2048, HN + (size_t)R * DM, lane);
        }
    }
#endif
    GRID_BAR();
#ifndef SKIP_P2
    {
        const bf16_t* WT = (const bf16_t*)(ws + WS_EVIN_T);
        { pg8::Gemm g{WT, HN, 2048, 2048, 2048, HN, WT + (size_t)4096 * 2048, nullptr, nullptr};
          P2Order S; S.S0.init(4096, MTOT, G, bid); S.S1.init(MTOT, 2048, G, bid); S.G = G; S.c = bid;
          EpiP2 E{EpiStoreBf16{(bf16_t*)(ws + WS_HPT), MTOT}, EpiProjBP{(bf16_t*)(ws + WS_A3), (bf16_t*)(ws + WS_SG)}};
          pg8::gemm_phase<EpiP2, P2Order>(lds, g, S, E); }
    }
#endif
    GRID_BAR();
#ifndef SKIP_P3
    {
#ifndef SKIP_S5A
        { pg8::Gemm g{(const bf16_t*)(ws + WS_A3), (const bf16_t*)(ws + WS_OPA1), 512, 256, 256}; pg8::S5Order S{G, bid};
          EpiS5E E{(float*)(ws + WS_E)};
          pg8::gemm_phase<EpiS5E, pg8::S5Order>(lds, g, S, E); }
#endif
        for (int rep = 0; rep < REP_HY; ++rep) {
        for (int it = bid; it < 1024; it += G) hyena_item<false>(a, ws, lds, it, rep == REP_HY - 1);
        for (int it = bid; it < 1024; it += G) hyena_item<true>(a, ws, lds, 1024 + it, rep == REP_HY - 1); }
    }
#endif
    GRID_BAR();
#ifndef SKIP_S5B
    for (int rep = 0; rep < REP_P3B; ++rep)
    { PHASE_IDS for (int it = gw; it < 512; it += NGW) s5_scan_item(ws, it, lane);
      LAS unsigned char* scr = lds + wid * 9216;
      if (NGW > 1024) { if (gw >= 512) for (int it = gw - 512; it < 4352; it += NGW - 512) hy_transpose_item(ws, scr, it, lane); }
      else { for (int it = NGW - 1 - gw; it < 4352; it += NGW) hy_transpose_item(ws, scr, it, lane); } }
#endif
    GRID_BAR();
#ifndef SKIP_S5C
    { pg8::Gemm g{(const bf16_t*)(ws + WS_A3), (const bf16_t*)(ws + WS_OPA3), 512, 512, 512}; pg8::S5Order S{G, bid};
      EpiS5Y E{(bf16_t*)(ws + WS_GB)};
      pg8::gemm_phase<EpiS5Y, pg8::S5Order>(lds, g, S, E); }
#endif
    GRID_BAR();
#ifndef SKIP_P4
    { pg8::Gemm g{(const bf16_t*)(ws + WS_GB), (const bf16_t*)(ws + WS_GLU_T), 1024, 1024, 1024}; pg8::StaticOrder S; S.init(MTOT, 1024, G, bid);
      EpiGlu E{(const bf16_t*)(ws + WS_GB), (const bf16_t*)(ws + WS_SG), a.in[I_GLUB], (bf16_t*)(ws + WS_MIXED)};
      pg8::gemm_phase<EpiGlu, pg8::StaticOrder>(lds, g, S, E); }
#endif
    GRID_BAR();
#ifndef SKIP_P5
    for (int rep = 0; rep < REP_P57; ++rep)
    {
        pg8::Gemm g{(const bf16_t*)(ws + WS_MIXED), (const bf16_t*)(ws + WS_EVOUT_T), 2048, 2048, 2048}; pg8::StaticOrder S; S.init(MTOT, 2048, G, bid);
        EpiOut0 E{a.in[I_X], a.in[I_CTX], mod, a.out, (float*)(ws + WS_CTX1)};
        pg8::gemm_phase<EpiOut0, pg8::StaticOrder>(lds, g, S, E);
    }
#endif
    GRID_BAR();
    for (int rep = 0; rep < REP_P6; ++rep)
    {
        PHASE_IDS
        LAS float* scr = (LAS float*)(lds + wid * 16768);
        constexpr int I_A = (2048 / 64) * (8192 / 32), I_B = (2048 / 64) * (2048 / 32);
        for (int it = gw; it < I_A + I_B; it += NGW) {
            if (it < I_A) transpose_item<true>(a.in[I_ODIN], 2048, 8192, (bf16_t*)(ws + WS_ODIN_T), scr, it, lane);
            else transpose_item<false>(a.in[I_ODOUT], 2048, 2048, (bf16_t*)(ws + WS_ODOUT_T), scr, it - I_A, lane);
        }
        const float* nw = a.in[I_NORMW] + DM; const float* mod1 = mod + 5 * 6144;
        for (int R = gw; R < MTOT; R += NGW) {
            const bool lat = R < MLAT; const int mrow = lat ? (R >> 12) : 4;
            const float* xr = lat ? a.out + (size_t)R * DM : (const float*)(ws + WS_CTX1) + (size_t)(R - MLAT) * DM;
            modnorm_row(xr, nw, mod1 + mrow * 6144, mod1 + mrow * 6144 + 2048, HN + (size_t)R * DM, lane);
        }
    }
    GRID_BAR();
    for (int rep = 0; rep < REP_P57; ++rep)
    {
        const bf16_t* WT = (const bf16_t*)(ws + WS_ODIN_T);
        const float* rope = (const float*)(ws + WS_ROPE);
        { pg8::Gemm g{HN, WT, 2048, 2048, 2048, HN + (size_t)MLAT * 2048, WT + (size_t)2048 * 2048, WT + (size_t)4096 * 2048, HN};
          P7Order S; S.Sa.init(MLAT, 24 * 256, G, bid); S.Sb.init(MCTX, 2048, G, bid); S.Sc.init(2048, MTOT, G, bid); S.G = G; S.c = bid;
          EpiQKG Ea{(bf16_t*)(ws + WS_Q), (bf16_t*)(ws + WS_K), (bf16_t*)(ws + WS_GATE1), a.in[I_QNORM], a.in[I_KNORM], rope, 0, 0};
          EpiP7 E{Ea, EpiVT{(bf16_t*)(ws + WS_VT)}};
          pg8::gemm_phase<EpiP7, P7Order>(lds, g, S, E); }
    }
    GRID_BAR();
    for (int rep = 0; rep < EXTRA_SYNC; ++rep) GRID_BAR();
    {
        float d1 = 0.f, d2 = 0.f;
        { const float* q1 = a.in[I_LQ1]; const float* k1 = a.in[I_LK1]; const float* q2 = a.in[I_LQ2]; const float* k2 = a.in[I_LK2];
          for (int i = 0; i < 64; ++i) { d1 += q1[i] * k1[i]; d2 += q2[i] * k2[i]; } }
        const float lam = expf(d1) - expf(d2) + LAM_INIT;
        for (int rep = 0; rep < REP_ATTN; ++rep)
        for (int u = bid; u < 2048; u += G) attn_unit(ws, lds, u >> 9, (u >> 5) & 15, u & 31, lam, a.in[I_SUBLN]);
    }
    GRID_BAR();
    {
        pg8::Gemm g{(const bf16_t*)(ws + WS_AO), (const bf16_t*)(ws + WS_ODOUT_T), 2048, 2048, 2048}; pg8::StaticOrder S; S.init(MLAT, 2048, G, bid);
        EpiOut1 E{mod + 5 * 6144, a.out};
        pg8::gemm_phase<EpiOut1, pg8::StaticOrder>(lds, g, S, E);
    }
}


extern "C" void kernel_launch(void* const* d_in, const int* in_sizes, int n_in, void* d_out, int out_size, void* d_ws, size_t ws_size, hipStream_t stream) {
    static int grid = 0;
    if (grid == 0) {
        int dev = 0, cus = 0, per_cu = 0;
        hipGetDevice(&dev);
        hipDeviceGetAttribute(&cus, hipDeviceAttributeMultiprocessorCount, dev);
        hipFuncSetAttribute((const void*)fwd_kernel, hipFuncAttributeMaxDynamicSharedMemorySize, LDS_BYTES);
        hipOccupancyMaxActiveBlocksPerMultiprocessor(&per_cu, (const void*)fwd_kernel, NTHREADS, LDS_BYTES);
        (void)hipGetLastError();
        grid = cus;
        if (ws_size < WS_NEED) { fprintf(stderr, "kernel_launch: workspace too small: %zu < %zu\n", ws_size, (size_t)WS_NEED); grid = -1; }
    }
    if (grid < 0) return;
    hipMemsetAsync((char*)d_ws + WS_CTL, 0, CTL_ZERO_BYTES, stream);
    Args a{};
    for (int i = 0; i < 38 && i < n_in; ++i) a.in[i] = (const float*)d_in[i];
    a.out = (float*)d_out; a.ws = (unsigned char*)d_ws;
    void* args[] = {&a};
    hipError_t e = hipLaunchCooperativeKernel((const void*)fwd_kernel, dim3(grid), dim3(NTHREADS), args, LDS_BYTES, stream);
    if (e != hipSuccess) fprintf(stderr, "cooperative launch failed: %s\n", hipGetErrorString(e));
}
```

```cpp
#include <hip/hip_runtime.h>
#include <hip/hip_cooperative_groups.h>
#include <cstdio>
#include <cstdint>
#include <cmath>
namespace cg = cooperative_groups;

#define LAS __attribute__((address_space(3)))
#define DI __device__ __forceinline__
typedef unsigned short bf16_t;
typedef short bf16x8 __attribute__((ext_vector_type(8)));
typedef float f32x4 __attribute__((ext_vector_type(4)));
typedef float f32x16 __attribute__((ext_vector_type(16)));
typedef unsigned u32x4 __attribute__((ext_vector_type(4)));
typedef unsigned u32x2 __attribute__((ext_vector_type(2)));
typedef float f32x2_t __attribute__((ext_vector_type(2)));
typedef __bf16 bf16x2_t __attribute__((ext_vector_type(2)));

DI unsigned cvtpk(float lo, float hi) { f32x2_t v = {lo, hi}; bf16x2_t b = __builtin_convertvector(v, bf16x2_t); return __builtin_bit_cast(unsigned, b); }
DI unsigned f2bf(float f) { return cvtpk(f, 0.f) & 0xffffu; }
DI float bf2f(unsigned short h) { return __uint_as_float(((unsigned)h) << 16); }
DI float bflo(unsigned w) { return __uint_as_float(w << 16); }
DI float bfhi(unsigned w) { return __uint_as_float(w & 0xffff0000u); }
DI float sigmoidf_(float x) { return __builtin_amdgcn_rcpf(1.f + __expf(-x)); }
DI float siluf_(float x) { return x * __builtin_amdgcn_rcpf(1.f + __expf(-x)); }
DI float gelu_tanh(float x) { const float u = 0.7978845608028654f * (x + 0.044715f * x * x * x); const float t = 1.f - 2.f * __builtin_amdgcn_rcpf(1.f + __expf(2.f * u)); return 0.5f * x * (1.f + t); }
DI int tid_opaque() { int t = threadIdx.x; asm volatile("" : "+v"(t)); return t; }
DI float wave_sum(float v) {
#pragma unroll
    for (int o = 1; o < 64; o <<= 1) v += __shfl_xor(v, o);
    return v;
}

constexpr int DM = 2048, NB = 4, SEQ = 4096, CTXL = 256;
constexpr int MLAT = NB * SEQ;
constexpr int MCTX = NB * CTXL;
constexpr int MTOT = MLAT + MCTX;
constexpr int EVEN_IN = 6144, ODD_IN = 8192;
constexpr float EPS = 1e-6f;
constexpr int NTHREADS = 512, NWAVES = 8;
constexpr int LDS_BYTES = 147456;
constexpr int REP_ATTN = 1, REP_HY = 1, REP_P1M = 1, REP_P3B = 1, REP_P6 = 1, REP_P57 = 1, REP_P2 = 1, EXTRA_SYNC = 0;

constexpr size_t MiB = 1u << 20;
constexpr size_t WS_CTL = 0;
constexpr size_t CTL_ZERO_BYTES = 1 * MiB;
constexpr size_t OFF_MOD = 4096;
constexpr size_t OFF_L1 = 512 * 1024;
constexpr size_t OFF_BAR = 600 * 1024;
constexpr size_t WS_EVIN_T = 1 * MiB;
constexpr size_t WS_EVOUT_T = WS_EVIN_T + (size_t)6144 * 2048 * 2;
constexpr size_t WS_GLU_T = WS_EVOUT_T + (size_t)2048 * 2048 * 2;
constexpr size_t WS_H2 = WS_GLU_T + (size_t)1024 * 1024 * 2;
constexpr size_t WS_ROPE = WS_H2 + (size_t)4352 * 64 * 4;
constexpr size_t WS_LAML = WS_ROPE + 8192;
constexpr size_t WS_L1P = WS_LAML + 64 * 1024;
static_assert(WS_L1P + 136 * 4096 * 4 <= 40 * MiB, "ws map");
constexpr size_t WS_REGION2 = 40 * MiB;
constexpr int GLAT_LEN = 8448, GCTX_LEN = 768;
constexpr size_t WS_GLAT = WS_REGION2;
constexpr size_t WS_GCTX = WS_GLAT + (size_t)2 * 1024 * GLAT_LEN * 2;
constexpr size_t WS_OPA1 = WS_GCTX + (size_t)2 * 1024 * GCTX_LEN * 2;
constexpr size_t WS_OPA3 = WS_OPA1 + (size_t)64 * 256 * 256 * 2;
constexpr size_t WS_REGION2_END = WS_OPA3 + (size_t)64 * 256 * 512 * 2;
constexpr size_t WS_ODIN_T = WS_REGION2;
constexpr size_t WS_ODOUT_T = WS_ODIN_T + (size_t)8192 * 2048 * 2;
static_assert(WS_ODOUT_T + (size_t)2048 * 2048 * 2 <= WS_REGION2_END, "region2 overlay");
constexpr size_t WS_CTX1 = 104 * MiB;
constexpr size_t WS_HN = 112 * MiB;
static_assert(WS_REGION2_END <= WS_CTX1, "ws map");
constexpr size_t WS_E = WS_HN;
constexpr size_t WS_HPT = WS_HN + (size_t)MTOT * 2048 * 2;
constexpr size_t WS_SG = WS_HPT + (size_t)4096 * MTOT * 2;
constexpr size_t WS_A3 = WS_SG + (size_t)MTOT * 1024 * 2;
constexpr size_t WS_MIXED = WS_A3 + (size_t)64 * 1280 * 512 * 2;
constexpr size_t WS_GB = WS_HN;
constexpr size_t WS_L0_END = WS_MIXED + (size_t)MTOT * 2048 * 2;
constexpr size_t WS_Q = WS_HPT;
constexpr size_t WS_K = WS_Q + (size_t)4 * 16 * 2 * 4096 * 64 * 2;
constexpr size_t WS_VT = WS_K + (size_t)4 * 16 * 2 * 4352 * 64 * 2;
constexpr size_t WS_GATE1 = WS_VT + (size_t)4 * 16 * 128 * 4352 * 2;
constexpr size_t WS_AO = WS_GATE1 + (size_t)MLAT * 2048 * 2;
constexpr size_t WS_L1_END = WS_AO + (size_t)MLAT * 2048 * 2;
constexpr size_t WS_NEED = (WS_L0_END > WS_L1_END ? WS_L0_END : WS_L1_END);
static_assert(WS_NEED <= (size_t)536870912, "ws budget");

namespace pg8 {
constexpr int BM = 256, BK = 64, HALF = 128, HTB = HALF * BK * 2, STAGE_BYTES = 8 * HTB, NXCD = 8, WGM = 8;
__host__ __device__ __forceinline__ int lds_byte(int r, int c) { const int st = (r >> 4) * 2 + (c >> 5), rr = r & 15, cc = c & 31, ob = rr * 64 + cc * 2; return st * 1024 + (ob ^ (((ob >> 9) & 1) << 5)); }
__host__ __device__ __forceinline__ void stage_rc(int b, int& R, int& C) { const int st = b / 1024, sb = b % 1024, swz = sb ^ (((sb >> 9) & 1) << 5); R = (st >> 1) * 16 + swz / 64; C = (st & 1) * 32 + (swz % 64) / 2; }
__host__ __device__ __forceinline__ int perm32(int rho) { const int n = rho >> 4, i = rho & 15; return 8 * (i >> 2) + 4 * n + (i & 3); }

struct Unit { int pm, pn, kind; };
struct Gemm { const bf16_t* A; const bf16_t* Bt; int lda, ldb, K; const bf16_t* A1; const bf16_t* Bt1; const bf16_t* A2; const bf16_t* Bt2; };

struct StaticOrder {
    int nM, nN, nwg, G, c;
    __device__ void init(int M, int N, int G_, int c_) { nM = M / BM; nN = N / BM; nwg = nM * nN; G = G_; c = c_; }
    __device__ bool next(int i, Unit& u) const { return map((long)i * G + c, u); }
    __device__ bool map(long L, Unit& u) const {
        if (L >= nwg) return false; u.kind = 0;
        int wgid = (int)L; { const int q = nwg / NXCD, r = nwg % NXCD, xcd = wgid % NXCD, off = wgid / NXCD; wgid = (xcd < r ? xcd * (q + 1) : r * (q + 1) + (xcd - r) * q) + off; }
        const int nig = WGM * nN, gid = wgid / nig, fm = gid * WGM, gsz = (nM - fm) < WGM ? (nM - fm) : WGM;
        u.pm = fm + ((wgid % nig) % gsz); u.pn = (wgid % nig) / gsz; return true;
    }
};
struct S5Order {
    int G, c;
    __device__ bool next(int i, Unit& u) const { const int L = i * G + c; if (L >= 320) return false; const int g = L / 5, t = L % 5; u.pm = g * 5 + t; u.pn = g; u.kind = 0; return true; }
};

template <class Epi, class Sched>
__device__ __forceinline__ void gemm_phase(LAS unsigned char* lds, const Gemm g, const Sched& S, const Epi& E) {
    const int tid = tid_opaque(), wid = __builtin_amdgcn_readfirstlane(tid >> 6), lane = tid & 63, wr = wid >> 2, wc = wid & 3, fr = lane & 15, fq = lane >> 4;
    const int K = g.K, nt = K / BK;
    unsigned voffA[2], voffB[2];
#pragma unroll
    for (int i = 0; i < 2; ++i) { int R, C; stage_rc(tid * 16 + i * 8192, R, C); const int Rb = Epi::PERM ? ((R & ~31) + perm32(R & 31)) : R;
        voffA[i] = (unsigned)(R * g.lda + C) * 2u; voffB[i] = (unsigned)(Rb * g.ldb + C) * 2u; }
    const size_t kstep = (size_t)(BK * 2);
    const size_t hstepA = (size_t)HALF * g.lda * 2, hstepB = (size_t)HALF * g.ldb * 2;
    const size_t tstepA = 2 * hstepA, tstepB = 2 * hstepB;
    const unsigned ldsw = (unsigned)wid * 1024u;
    const int aoff = lds_byte(wr * 64 + fr, fq * 8), boff = lds_byte(wc * 32 + fr, fq * 8);
#define PG8_SA(b, h) (((b) * 2 + (h)) * HTB)
#define PG8_SB(b, h) ((4 + (b) * 2 + (h)) * HTB)
#define PG8_STAGE(bufoff, gbase, voff) do { _Pragma("unroll") for (int _i = 0; _i < 2; ++_i) \
        __builtin_amdgcn_global_load_lds((const unsigned*)((const char*)(gbase) + (voff)[_i]), (LAS unsigned*)(lds + (bufoff) + ldsw + _i * 8192), 16, 0, 0); } while (0)
#define PG8_LDA(dst, b, h) do { _Pragma("unroll") for (int m = 0; m < 4; ++m) _Pragma("unroll") for (int k = 0; k < 2; ++k) dst[m][k] = *(const LAS bf16x8*)(lds + PG8_SA(b, h) + aoff + m * 2048 + k * 1024); } while (0)
#define PG8_LDB(dst, b, h) do { _Pragma("unroll") for (int n = 0; n < 2; ++n) _Pragma("unroll") for (int k = 0; k < 2; ++k) dst[n][k] = *(const LAS bf16x8*)(lds + PG8_SB(b, h) + boff + n * 2048 + k * 1024); } while (0)
#define PG8_MMA(ai, bj, At, Bt) do { __builtin_amdgcn_s_setprio(1); _Pragma("unroll") for (int m = 0; m < 4; ++m) _Pragma("unroll") for (int n = 0; n < 2; ++n) _Pragma("unroll") for (int k = 0; k < 2; ++k) \
        acc[ai][bj][m][n] = __builtin_amdgcn_mfma_f32_16x16x32_bf16(Bt[n][k], At[m][k], acc[ai][bj][m][n], 0, 0, 0); __builtin_amdgcn_s_setprio(0); } while (0)
#define PG8_WAIT_V(n) asm volatile("s_waitcnt vmcnt(" #n ")" ::: "memory")
#define PG8_WAIT_L(n) asm volatile("s_waitcnt lgkmcnt(" #n ")" ::: "memory")
#define PG8_BAR __builtin_amdgcn_s_barrier()
#define PG8_SCHED __builtin_amdgcn_sched_barrier(0)
    Unit cur, nxt; int ui = 0;
    if (!S.next(0, cur)) return;
    f32x4 acc[2][2][4][2];
#pragma unroll
    for (int a = 0; a < 2; ++a)
#pragma unroll
        for (int b = 0; b < 2; ++b)
#pragma unroll
            for (int m = 0; m < 4; ++m)
#pragma unroll
                for (int n = 0; n < 2; ++n) acc[a][b][m][n] = (f32x4){0.f, 0.f, 0.f, 0.f};
    bf16x8 At[4][2], B0[2][2], B1[2][2];
#define PG8_ABASE(u) ((const char*)((u).kind == 0 ? g.A : ((u).kind == 1 ? g.A1 : g.A2)) + (size_t)(u).pm * tstepA)
#define PG8_BBASE(u) ((const char*)((u).kind == 0 ? g.Bt : ((u).kind == 1 ? g.Bt1 : g.Bt2)) + (size_t)(u).pn * tstepB)
    const char* cA = PG8_ABASE(cur); const char* cB = PG8_BBASE(cur);
    PG8_STAGE(PG8_SB(0, 0), cB, voffB); PG8_STAGE(PG8_SB(0, 1), cB + hstepB, voffB); PG8_STAGE(PG8_SA(0, 0), cA, voffA); PG8_STAGE(PG8_SA(0, 1), cA + hstepA, voffA);
    if (wr == 1) PG8_BAR;
    PG8_WAIT_V(2); PG8_BAR;
    PG8_STAGE(PG8_SB(1, 0), cB + kstep, voffB); PG8_STAGE(PG8_SA(1, 0), cA + kstep, voffA); PG8_STAGE(PG8_SB(1, 1), cB + hstepB + kstep, voffB);
    PG8_WAIT_V(6); PG8_BAR;
    for (;;) {
        const bool has_next = S.next(ui + 1, nxt);
        const char* nA = has_next ? PG8_ABASE(nxt) : cA; const char* nB = has_next ? PG8_BBASE(nxt) : cB;
        for (int t = 0; t < nt; t += 2) {
            const bool last = (t == nt - 2);
            const char* a1 = cA + (size_t)(t + 1) * kstep;
            const char* a2 = last ? nA : cA + (size_t)(t + 2) * kstep; const char* b2 = last ? nB : cB + (size_t)(t + 2) * kstep;
            const char* a3 = a2 + kstep; const char* b3 = b2 + kstep;
            PG8_LDB(B0, 0, 0); PG8_LDB(B1, 0, 1); PG8_SCHED; PG8_LDA(At, 0, 0); PG8_STAGE(PG8_SA(1, 1), a1 + hstepA, voffA);
            PG8_WAIT_V(8); PG8_WAIT_L(0); PG8_BAR; PG8_MMA(0, 0, At, B0); PG8_MMA(0, 1, At, B1); PG8_BAR; PG8_SCHED;
            PG8_LDA(At, 0, 1); PG8_STAGE(PG8_SB(0, 0), b2, voffB); PG8_STAGE(PG8_SB(0, 1), b2 + hstepB, voffB); PG8_STAGE(PG8_SA(0, 0), a2, voffA);
            PG8_WAIT_V(8); PG8_WAIT_L(0); PG8_BAR; PG8_MMA(1, 0, At, B0); PG8_MMA(1, 1, At, B1); PG8_BAR; PG8_SCHED;
            PG8_LDB(B0, 1, 0); PG8_LDB(B1, 1, 1); PG8_SCHED; PG8_LDA(At, 1, 0); PG8_STAGE(PG8_SA(0, 1), a2 + hstepA, voffA);
            PG8_WAIT_V(8); PG8_WAIT_L(0); PG8_BAR; PG8_MMA(0, 0, At, B0); PG8_MMA(0, 1, At, B1); PG8_BAR; PG8_SCHED;
            PG8_LDA(At, 1, 1); PG8_STAGE(PG8_SB(1, 0), b3, voffB); PG8_STAGE(PG8_SB(1, 1), b3 + hstepB, voffB); PG8_STAGE(PG8_SA(1, 0), a3, voffA);
            PG8_WAIT_V(8); PG8_WAIT_L(0); PG8_BAR; PG8_MMA(1, 0, At, B0); PG8_MMA(1, 1, At, B1); PG8_BAR; PG8_SCHED;
        }
        if (wr == 0) PG8_BAR;
        E(acc, cur, wr, wc, fr, fq);
        if (!has_next) break;
#pragma unroll
        for (int a = 0; a < 2; ++a)
#pragma unroll
            for (int b = 0; b < 2; ++b)
#pragma unroll
                for (int m = 0; m < 4; ++m)
#pragma unroll
                    for (int n = 0; n < 2; ++n) acc[a][b][m][n] = (f32x4){0.f, 0.f, 0.f, 0.f};
        cur = nxt; cA = nA; cB = nB; ++ui;
        if (wr == 1) PG8_BAR;
    }
    PG8_WAIT_V(0);
    PG8_BAR;
#undef PG8_ABASE
#undef PG8_BBASE
#undef PG8_SA
#undef PG8_SB
#undef PG8_STAGE
#undef PG8_LDA
#undef PG8_LDB
#undef PG8_MMA
#undef PG8_WAIT_V
#undef PG8_WAIT_L
#undef PG8_BAR
#undef PG8_SCHED
}
}
using pg8::Unit;
typedef f32x4 AccT[2][2][4][2];

DI void row_to_chunk(int R, int& n, int& tau) {
    if (R < MLAT) { const int b = R >> 12, t = R & 4095; n = b * 272 + 16 + (t >> 4); tau = t & 15; }
    else { const int r2 = R - MLAT, b = r2 >> 8, t = r2 & 255; n = b * 272 + (t >> 4); tau = t & 15; }
}

struct EpiStoreBf16 {
    static constexpr bool PERM = true;
    bf16_t* O; int ldc;
    DI void operator()(const AccT& acc, const Unit& u, int wr, int wc, int fr, int fq) const {
        const int row0 = u.pm * 256 + wr * 64 + fr, col0 = u.pn * 256 + wc * 32 + 8 * fq;
#pragma unroll
        for (int ai = 0; ai < 2; ++ai)
#pragma unroll
            for (int m = 0; m < 4; ++m) { bf16_t* rowp = O + (size_t)(row0 + ai * 128 + m * 16) * ldc + col0;
#pragma unroll
                for (int bj = 0; bj < 2; ++bj) { const f32x4 v0 = acc[ai][bj][m][0], v1 = acc[ai][bj][m][1];
                    u32x4 w; w.x = cvtpk(v0[0], v0[1]); w.y = cvtpk(v0[2], v0[3]); w.z = cvtpk(v1[0], v1[1]); w.w = cvtpk(v1[2], v1[3]);
                    *(u32x4*)(rowp + bj * 128) = w; } }
    }
};
struct EpiProjB {
    static constexpr bool PERM = false;
    bf16_t* A3; bf16_t* SG;
    DI void operator()(const AccT& acc, const Unit& u, int wr, int wc, int fr, int fq) const {
        const bool is_su = u.pn < 4;
#pragma unroll
        for (int ai = 0; ai < 2; ++ai)
#pragma unroll
            for (int m = 0; m < 4; ++m) {
                const int R = u.pm * 256 + ai * 128 + wr * 64 + m * 16 + fr;
                int n, tau; row_to_chunk(R, n, tau);
#pragma unroll
                for (int bj = 0; bj < 2; ++bj)
#pragma unroll
                    for (int nn = 0; nn < 2; ++nn) {
                        const int col = u.pn * 256 + bj * 128 + wc * 32 + nn * 16 + fq * 4;
                        const f32x4 v = acc[ai][bj][m][nn];
                        u32x2 w; w.x = cvtpk(v[0], v[1]); w.y = cvtpk(v[2], v[3]);
                        if (is_su) { const int g = col >> 4, c = col & 15; *(u32x2*)(A3 + ((size_t)(g * 1280 + n) * 512 + tau * 16 + c)) = w; }
                        else { *(u32x2*)(SG + (size_t)R * 1024 + (col - 1024)) = w; }
                    }
            }
    }
};
struct EpiOut0 {
    static constexpr bool PERM = false;
    const float* x; const float* ctx; const float* mod0; float* out; float* ctx1;
    DI void operator()(const AccT& acc, const Unit& u, int wr, int wc, int fr, int fq) const {
        const int R0 = u.pm * 256;
        const bool lat = R0 < MLAT;
        const int mrow = lat ? (R0 >> 12) : 4;
        const float* gate = mod0 + mrow * 6144 + 4096;
        const float* srcb = lat ? x + (size_t)R0 * DM : ctx + (size_t)(R0 - MLAT) * DM;
        float* dstb = lat ? out + (size_t)R0 * DM : ctx1 + (size_t)(R0 - MLAT) * DM;
        const int colb = u.pn * 256 + wc * 32 + fq * 4;
        f32x4 gv[2][2];
#pragma unroll
        for (int bj = 0; bj < 2; ++bj)
#pragma unroll
            for (int nn = 0; nn < 2; ++nn) gv[bj][nn] = *(const f32x4*)(gate + colb + bj * 128 + nn * 16);
#pragma unroll
        for (int ai = 0; ai < 2; ++ai) {
            f32x4 xv[4][2][2];
#pragma unroll
            for (int m = 0; m < 4; ++m)
#pragma unroll
                for (int bj = 0; bj < 2; ++bj)
#pragma unroll
                    for (int nn = 0; nn < 2; ++nn) xv[m][bj][nn] = *(const f32x4*)(srcb + (size_t)(ai * 128 + wr * 64 + m * 16 + fr) * DM + colb + bj * 128 + nn * 16);
#pragma unroll
            for (int m = 0; m < 4; ++m)
#pragma unroll
                for (int bj = 0; bj < 2; ++bj)
#pragma unroll
                    for (int nn = 0; nn < 2; ++nn) *(f32x4*)(dstb + (size_t)(ai * 128 + wr * 64 + m * 16 + fr) * DM + colb + bj * 128 + nn * 16) = xv[m][bj][nn] + gv[bj][nn] * acc[ai][bj][m][nn];
        }
    }
};


struct EpiS5E {
    static constexpr bool PERM = false;
    float* E;
    DI void operator()(const AccT& acc, const Unit& u, int wr, int wc, int fr, int fq) const {
        const int g = u.pn, tile = u.pm - 5 * g;
#pragma unroll
        for (int ai = 0; ai < 2; ++ai)
#pragma unroll
            for (int m = 0; m < 4; ++m) {
                const int n = tile * 256 + ai * 128 + wr * 64 + m * 16 + fr;
                if (n < 1088) {
                    float* rowp = E + (size_t)(g * 1088 + n) * 256;
#pragma unroll
                    for (int bj = 0; bj < 2; ++bj)
#pragma unroll
                        for (int nn = 0; nn < 2; ++nn) *(f32x4*)(rowp + bj * 128 + wc * 32 + nn * 16 + fq * 4) = acc[ai][bj][m][nn];
                }
            }
    }
};
struct EpiS5Y {
    static constexpr bool PERM = false;
    bf16_t* GB;
    DI void operator()(const AccT& acc, const Unit& u, int wr, int wc, int fr, int fq) const {
        const int g = u.pn, tile = u.pm - 5 * g;
#pragma unroll
        for (int ai = 0; ai < 2; ++ai)
#pragma unroll
            for (int m = 0; m < 4; ++m) {
                const int n = tile * 256 + ai * 128 + wr * 64 + m * 16 + fr;
                if (n < 1088) {
                    const int b = n / 272, kc = n - b * 272;
                    const int R0 = kc < 16 ? MLAT + b * 256 + kc * 16 : b * 4096 + (kc - 16) * 16;
#pragma unroll
                    for (int bj = 0; bj < 2; ++bj)
#pragma unroll
                        for (int nn = 0; nn < 2; ++nn) {
                            const int kk = bj * 128 + wc * 32 + nn * 16 + fq * 4, t = kk >> 4, co = kk & 15;
                            const f32x4 v = acc[ai][bj][m][nn];
                            u32x2 w; w.x = cvtpk(gelu_tanh(v[0]), gelu_tanh(v[1])); w.y = cvtpk(gelu_tanh(v[2]), gelu_tanh(v[3]));
                            *(u32x2*)(GB + (size_t)(R0 + t) * 1024 + g * 16 + co) = w;
                        }
                }
            }
    }
};
struct EpiGlu {
    static constexpr bool PERM = false;
    const bf16_t* GB; const bf16_t* SG; const float* bias; bf16_t* MIXED;
    DI void operator()(const AccT& acc, const Unit& u, int wr, int wc, int fr, int fq) const {
        const int colb = u.pn * 256 + wc * 32 + fq * 4;
        f32x4 bv[2][2];
#pragma unroll
        for (int bj = 0; bj < 2; ++bj)
#pragma unroll
            for (int nn = 0; nn < 2; ++nn) bv[bj][nn] = *(const f32x4*)(bias + colb + bj * 128 + nn * 16);
#pragma unroll
        for (int ai = 0; ai < 2; ++ai) {
            u32x2 gw[4][2][2], sw[4][2][2];
#pragma unroll
            for (int m = 0; m < 4; ++m) { const size_t R = (size_t)(u.pm * 256 + ai * 128 + wr * 64 + m * 16 + fr);
#pragma unroll
                for (int bj = 0; bj < 2; ++bj)
#pragma unroll
                    for (int nn = 0; nn < 2; ++nn) { const int col = colb + bj * 128 + nn * 16; gw[m][bj][nn] = *(const u32x2*)(GB + R * 1024 + col); sw[m][bj][nn] = *(const u32x2*)(SG + R * 1024 + col); } }
#pragma unroll
            for (int m = 0; m < 4; ++m) { const size_t R = (size_t)(u.pm * 256 + ai * 128 + wr * 64 + m * 16 + fr);
#pragma unroll
                for (int bj = 0; bj < 2; ++bj)
#pragma unroll
                    for (int nn = 0; nn < 2; ++nn) {
                        const int col = colb + bj * 128 + nn * 16;
                        const f32x4 v = acc[ai][bj][m][nn] + bv[bj][nn];
                        const u32x2 g = gw[m][bj][nn], sg = sw[m][bj][nn];
                        u32x2 w; w.x = cvtpk(bflo(g.x) * sigmoidf_(v[0]) * siluf_(bflo(sg.x)), bfhi(g.x) * sigmoidf_(v[1]) * siluf_(bfhi(sg.x)));
                        w.y = cvtpk(bflo(g.y) * sigmoidf_(v[2]) * siluf_(bflo(sg.y)), bfhi(g.y) * sigmoidf_(v[3]) * siluf_(bfhi(sg.y)));
                        *(u32x2*)(MIXED + R * 2048 + 1024 + col) = w;
                    } }
        }
    }
};

constexpr float QSCALE = 0.125f * 1.4426950408889634f;
constexpr float LAM_INIT = 0.35550906759096335f;
struct QKGOrder {
    pg8::StaticOrder S;
    __device__ bool next(int i, Unit& u) const { if (!S.next(i, u)) return false; if (u.pn >= 16) u.pn += 8; return true; }
};
struct EpiQKG {
    static constexpr bool PERM = true;
    bf16_t* Q; bf16_t* K; bf16_t* GATE; const float* qn; const float* kn; const float* rope; int row_off, pn_off;
    DI void operator()(const AccT& acc, const Unit& u, int wr, int wc, int fr, int fq) const {
        const int pn = u.pn + pn_off;
        if (pn >= 24) {
#pragma unroll
            for (int ai = 0; ai < 2; ++ai)
#pragma unroll
                for (int m = 0; m < 4; ++m) {
                    const int R = row_off + u.pm * 256 + ai * 128 + wr * 64 + m * 16 + fr;
#pragma unroll
                    for (int bj = 0; bj < 2; ++bj) {
                        const int col = (pn - 24) * 256 + bj * 128 + wc * 32 + 8 * fq;
                        const f32x4 v0 = acc[ai][bj][m][0], v1 = acc[ai][bj][m][1];
                        u32x4 w; w.x = cvtpk(siluf_(v0[0]), siluf_(v0[1])); w.y = cvtpk(siluf_(v0[2]), siluf_(v0[3])); w.z = cvtpk(siluf_(v1[0]), siluf_(v1[1])); w.w = cvtpk(siluf_(v1[2]), siluf_(v1[3]));
                        *(u32x4*)(GATE + (size_t)R * 2048 + col) = w;
                    }
                }
            return;
        }
        const bool isq = pn < 8;
        const int hm = 4 * (pn & 7) + wc, h = hm >> 1, mp = hm & 1;
        const float* nw = isq ? qn : kn;
        f32x4 w[2][2];
#pragma unroll
        for (int bj = 0; bj < 2; ++bj)
#pragma unroll
            for (int nn = 0; nn < 2; ++nn) w[bj][nn] = *(const f32x4*)(nw + 32 * bj + 16 * nn + 4 * fq);
#pragma unroll
        for (int ai = 0; ai < 2; ++ai) {
            const bool lat = (row_off + u.pm * 256) < MLAT;
            f32x4 cs[4][2], sn[4][2];
            if (lat) {
#pragma unroll
                for (int m = 0; m < 4; ++m) { const int t = (row_off + u.pm * 256 + ai * 128 + wr * 64 + m * 16 + fr) & 4095;
#pragma unroll
                    for (int bj = 0; bj < 2; ++bj) { const int pos = bj == 0 ? (t >> 6) : (t & 63); cs[m][bj] = *(const f32x4*)(rope + pos * 32 + 4 * fq); sn[m][bj] = *(const f32x4*)(rope + pos * 32 + 16 + 4 * fq); } }
            }
#pragma unroll
            for (int m = 0; m < 4; ++m) {
                const int R = row_off + u.pm * 256 + ai * 128 + wr * 64 + m * 16 + fr;
                float ss = 0.f;
#pragma unroll
                for (int bj = 0; bj < 2; ++bj)
#pragma unroll
                    for (int nn = 0; nn < 2; ++nn) { const f32x4 v = acc[ai][bj][m][nn]; ss += (v[0] * v[0] + v[1] * v[1]) + (v[2] * v[2] + v[3] * v[3]); }
                ss += __shfl_xor(ss, 16); ss += __shfl_xor(ss, 32);
                const float rstd = __builtin_amdgcn_rsqf(ss * (1.0f / 64.0f) + EPS);
                const int b = lat ? (R >> 12) : ((R - MLAT) >> 8);
                const int t = lat ? (R & 4095) : ((R - MLAT) & 255);
                bf16_t* dst = isq ? Q + ((size_t)((b * 16 + h) * 2 + mp) * 4096 + t) * 64
                                  : K + ((size_t)((b * 16 + h) * 2 + mp) * 4352 + (lat ? 256 + t : t)) * 64;
#pragma unroll
                for (int bj = 0; bj < 2; ++bj) {
                    f32x4 x1 = acc[ai][bj][m][0] * rstd * w[bj][0], x2 = acc[ai][bj][m][1] * rstd * w[bj][1];
                    if (lat) { const f32x4 o1 = x1 * cs[m][bj] - x2 * sn[m][bj], o2 = x1 * sn[m][bj] + x2 * cs[m][bj]; x1 = o1; x2 = o2; }
                    if (isq) { x1 = x1 * QSCALE; x2 = x2 * QSCALE; }
                    u32x2 p1, p2; p1.x = cvtpk(x1[0], x1[1]); p1.y = cvtpk(x1[2], x1[3]); p2.x = cvtpk(x2[0], x2[1]); p2.y = cvtpk(x2[2], x2[3]);
                    *(u32x2*)(dst + 32 * bj + 4 * fq) = p1; *(u32x2*)(dst + 32 * bj + 16 + 4 * fq) = p2;
                }
            }
        }
    }
};
struct EpiVT {
    static constexpr bool PERM = true;
    bf16_t* VT;
    DI void operator()(const AccT& acc, const Unit& u, int wr, int wc, int fr, int fq) const {
        const int R0 = u.pn * 256;
        const bool lat = R0 < MLAT;
        const int b = lat ? (R0 >> 12) : ((R0 - MLAT) >> 8);
        const int kv0 = lat ? 256 + (R0 & 4095) : ((R0 - MLAT) & 255);
#pragma unroll
        for (int ai = 0; ai < 2; ++ai)
#pragma unroll
            for (int m = 0; m < 4; ++m) {
                const int vc = u.pm * 256 + ai * 128 + wr * 64 + m * 16 + fr, h = vc >> 7, e = vc & 127;
                bf16_t* rowp = VT + ((size_t)((b * 16 + h) * 128 + e)) * 4352 + kv0 + wc * 32 + 8 * fq;
#pragma unroll
                for (int bj = 0; bj < 2; ++bj) { const f32x4 v0 = acc[ai][bj][m][0], v1 = acc[ai][bj][m][1];
                    u32x4 w; w.x = cvtpk(v0[0], v0[1]); w.y = cvtpk(v0[2], v0[3]); w.z = cvtpk(v1[0], v1[1]); w.w = cvtpk(v1[2], v1[3]);
                    *(u32x4*)(rowp + bj * 128) = w; }
            }
    }
};
struct EpiOut1 {
    static constexpr bool PERM = false;
    const float* mod1; float* out;
    DI void operator()(const AccT& acc, const Unit& u, int wr, int wc, int fr, int fq) const {
        const int R0 = u.pm * 256;
        const float* gate = mod1 + (R0 >> 12) * 6144 + 4096;
        float* dstb = out + (size_t)R0 * DM;
        const int colb = u.pn * 256 + wc * 32 + fq * 4;
        f32x4 gv[2][2];
#pragma unroll
        for (int bj = 0; bj < 2; ++bj)
#pragma unroll
            for (int nn = 0; nn < 2; ++nn) gv[bj][nn] = *(const f32x4*)(gate + colb + bj * 128 + nn * 16);
#pragma unroll
        for (int ai = 0; ai < 2; ++ai) {
            f32x4 xv[4][2][2];
#pragma unroll
            for (int m = 0; m < 4; ++m)
#pragma unroll
                for (int bj = 0; bj < 2; ++bj)
#pragma unroll
                    for (int nn = 0; nn < 2; ++nn) xv[m][bj][nn] = *(const f32x4*)(dstb + (size_t)(ai * 128 + wr * 64 + m * 16 + fr) * DM + colb + bj * 128 + nn * 16);
#pragma unroll
            for (int m = 0; m < 4; ++m)
#pragma unroll
                for (int bj = 0; bj < 2; ++bj)
#pragma unroll
                    for (int nn = 0; nn < 2; ++nn) *(f32x4*)(dstb + (size_t)(ai * 128 + wr * 64 + m * 16 + fr) * DM + colb + bj * 128 + nn * 16) = xv[m][bj][nn] + gv[bj][nn] * acc[ai][bj][m][nn];
        }
    }
};

struct EpiHyT {
    static constexpr bool PERM = false;
    bf16_t* O;
    DI void operator()(const AccT& acc, const Unit& u, int wr, int wc, int fr, int fq) const {
#pragma unroll
        for (int ai = 0; ai < 2; ++ai)
#pragma unroll
            for (int m = 0; m < 4; ++m) { bf16_t* rowp = O + (size_t)(u.pm * 256 + ai * 128 + wr * 64 + m * 16 + fr) * MTOT + u.pn * 256 + wc * 32 + 4 * fq;
#pragma unroll
                for (int bj = 0; bj < 2; ++bj)
#pragma unroll
                    for (int nn = 0; nn < 2; ++nn) { const f32x4 v = acc[ai][bj][m][nn]; u32x2 w; w.x = cvtpk(v[0], v[1]); w.y = cvtpk(v[2], v[3]); *(u32x2*)(rowp + bj * 128 + nn * 16) = w; } }
    }
};

struct EpiProjBP {
    static constexpr bool PERM = true;
    bf16_t* A3; bf16_t* SG;
    DI void operator()(const AccT& acc, const Unit& u, int wr, int wc, int fr, int fq) const {
        const bool is_su = u.pn < 4;
#pragma unroll
        for (int ai = 0; ai < 2; ++ai)
#pragma unroll
            for (int m = 0; m < 4; ++m) {
                const int R = u.pm * 256 + ai * 128 + wr * 64 + m * 16 + fr;
                int n, tau; row_to_chunk(R, n, tau);
#pragma unroll
                for (int bj = 0; bj < 2; ++bj) {
                    const int col = u.pn * 256 + bj * 128 + wc * 32 + 8 * fq;
                    const f32x4 v0 = acc[ai][bj][m][0], v1 = acc[ai][bj][m][1];
                    u32x4 w; w.x = cvtpk(v0[0], v0[1]); w.y = cvtpk(v0[2], v0[3]); w.z = cvtpk(v1[0], v1[1]); w.w = cvtpk(v1[2], v1[3]);
                    if (is_su) { const int g = col >> 4, c = col & 15; *(u32x4*)(A3 + ((size_t)(g * 1280 + n) * 512 + tau * 16 + c)) = w; }
                    else { *(u32x4*)(SG + (size_t)R * 1024 + (col - 1024)) = w; }
                }
            }
    }
};
struct P2Order { pg8::StaticOrder S0, S1; int G, c;
    __device__ bool next(int i, Unit& u) const { const long L = (long)i * G + c; if (L < S0.nwg) return S0.map(L, u); if (!S1.map(L - S0.nwg, u)) return false; u.kind = 1; return true; } };
struct EpiP2 { static constexpr bool PERM = true; EpiStoreBf16 e0; EpiProjBP e1;
    DI void operator()(const AccT& acc, const Unit& u, int wr, int wc, int fr, int fq) const { if (u.kind == 0) e0(acc, u, wr, wc, fr, fq); else e1(acc, u, wr, wc, fr, fq); } };
struct EpiVTn {
    static constexpr bool PERM = false;
    bf16_t* VT;
    DI void operator()(const AccT& acc, const Unit& u, int wr, int wc, int fr, int fq) const {
        const int R0 = u.pn * 256; const bool lat = R0 < MLAT;
        const int b = lat ? (R0 >> 12) : ((R0 - MLAT) >> 8);
        const int kv0 = lat ? 256 + (R0 & 4095) : ((R0 - MLAT) & 255);
#pragma unroll
        for (int ai = 0; ai < 2; ++ai)
#pragma unroll
            for (int m = 0; m < 4; ++m) {
                const int vc = u.pm * 256 + ai * 128 + wr * 64 + m * 16 + fr, h = vc >> 7, e = vc & 127;
                bf16_t* rowp = VT + ((size_t)((b * 16 + h) * 128 + e)) * 4352 + kv0 + wc * 32 + 4 * fq;
#pragma unroll
                for (int bj = 0; bj < 2; ++bj)
#pragma unroll
                    for (int nn = 0; nn < 2; ++nn) { const f32x4 v = acc[ai][bj][m][nn]; u32x2 w; w.x = cvtpk(v[0], v[1]); w.y = cvtpk(v[2], v[3]); *(u32x2*)(rowp + bj * 128 + nn * 16) = w; }
            }
    }
};
struct P7Order { pg8::StaticOrder Sa, Sb, Sc; int G, c;
    __device__ bool next(int i, Unit& u) const { long L = (long)i * G + c;
        if (L < Sa.nwg) { Sa.map(L, u); if (u.pn >= 16) u.pn += 8; return true; } L -= Sa.nwg;
        if (L < Sc.nwg) { Sc.map(L, u); u.kind = 2; return true; } L -= Sc.nwg;
        if (!Sb.map(L, u)) return false; u.kind = 1; return true; } };
struct EpiP7 { static constexpr bool PERM = true; EpiQKG ea; EpiVT ec;
    DI void operator()(const AccT& acc, const Unit& u, int wr, int wc, int fr, int fq) const {
        if (u.kind == 2) { ec(acc, u, wr, wc, fr, fq); return; }
        EpiQKG e = ea; e.row_off = u.kind ? MLAT : 0; e.pn_off = u.kind ? 8 : 0; e(acc, u, wr, wc, fr, fq); } };

template <bool QKPERM>
DI void transpose_item(const float* W, int K, int N, bf16_t* WT, LAS float* scr, int item, int lane) {
    const int nblk = N / 32, kb = item / nblk, nb = item % nblk, k0 = 64 * kb, n0 = 32 * nb;
#pragma unroll
    for (int i = 0; i < 32; ++i) { const int kk = 2 * i + (lane >> 5); scr[kk * 33 + (lane & 31)] = W[(size_t)(k0 + kk) * N + n0 + (lane & 31)]; }
    asm volatile("s_waitcnt lgkmcnt(0)" ::: "memory");
    const int c = lane & 7;
#pragma unroll
    for (int j = 0; j < 4; ++j) { const int n = (lane >> 3) + 8 * j; const LAS float* s = scr + (8 * c) * 33 + n;
        u32x4 o; o.x = cvtpk(s[0 * 33], s[1 * 33]); o.y = cvtpk(s[2 * 33], s[3 * 33]); o.z = cvtpk(s[4 * 33], s[5 * 33]); o.w = cvtpk(s[6 * 33], s[7 * 33]);
        int nr = n0 + n;
        if (QKPERM && nr < 4096) { const int cc = nr & 255, d = cc & 31; nr = (nr & ~255) + 128 * ((cc >> 5) & 1) + 32 * (cc >> 6) + 8 * ((d >> 2) & 3) + 4 * (d >> 4) + (d & 3); }
        *(u32x4*)(WT + (size_t)nr * K + k0 + 8 * c) = o; }
    asm volatile("s_waitcnt lgkmcnt(0)" ::: "memory");
}

struct Args { const float* in[38]; float* out; unsigned char* ws; };

enum { I_X = 0, I_C, I_CTX, I_CCTX, I_MODW, I_MODB, I_NORMW, I_EVIN, I_EVOUT, I_HYCW, I_HYCB, I_HYW1, I_HYB1, I_HYW2, I_HYB2, I_HYW3, I_HYB3, I_HYFREQ, I_HYSKIP,
       I_S5ARE, I_S5AIM, I_S5LOGDT, I_S5BRE, I_S5BIM, I_S5CRE, I_S5CIM, I_S5D, I_GLUW, I_GLUB, I_ODIN, I_ODOUT, I_QNORM, I_KNORM, I_LQ1, I_LK1, I_LQ2, I_LK2, I_SUBLN };

DI void mod_item(const Args& a, float* mod, LAS float* scr, int item, int lane) {
    const int kc = item & 31, cg_ = (item >> 5) % 24, l = item / (32 * 24);
    const float* cv = a.in[I_C]; const float* cc = a.in[I_CCTX];
    for (int e = lane; e < 5 * 64; e += 64) { const int r = e >> 6, k = kc * 64 + (e & 63); const float v = (r < 4) ? cv[r * DM + k] : cc[k]; scr[e] = siluf_(v); }
    asm volatile("s_waitcnt lgkmcnt(0)" ::: "memory");
    const float* W = a.in[I_MODW] + (size_t)l * DM * 6144 + (size_t)(kc * 64) * 6144 + cg_ * 256 + lane * 4;
    f32x4 acc[5];
#pragma unroll
    for (int r = 0; r < 5; ++r) acc[r] = (f32x4){0.f, 0.f, 0.f, 0.f};
#pragma unroll 16
    for (int k = 0; k < 64; ++k) { const f32x4 w = *(const f32x4*)(W + (size_t)k * 6144);
#pragma unroll
        for (int r = 0; r < 5; ++r) acc[r] += w * scr[r * 64 + k]; }
    const int col = cg_ * 256 + lane * 4;
    if (kc == 0) { const f32x4 b = *(const f32x4*)(a.in[I_MODB] + l * 6144 + col);
#pragma unroll
        for (int r = 0; r < 5; ++r) acc[r] += b; }
#pragma unroll
    for (int r = 0; r < 5; ++r)
#pragma unroll
        for (int e = 0; e < 4; ++e) unsafeAtomicAdd(mod + (size_t)(l * 5 + r) * 6144 + col + e, acc[r][e]);
    asm volatile("s_waitcnt lgkmcnt(0)" ::: "memory");
}
DI void h2_item(const Args& a, float* h2buf, LAS float* scr, const LAS float* w2s, int item, int lane) {
    const float* w1 = a.in[I_HYW1]; const float* fr = a.in[I_HYFREQ];
    float w1c[33];
#pragma unroll
    for (int i = 0; i < 33; ++i) w1c[i] = w1[i * 64 + lane];
    const float b1v = a.in[I_HYB1][lane], b2v = a.in[I_HYB2][lane], f0 = fr[lane], f1 = fr[64 + lane];
    const bool isctx = item >= 512; const int n = isctx ? 256 : 4096; const int t0 = (isctx ? item - 512 : item) * 8; const int row0 = (isctx ? 4096 : 0) + t0;
#pragma unroll 1
    for (int q = 0; q < 8; ++q) {
        const float tf = (float)(t0 + q);
        { const int i = lane & 15; const float band = 1e-4f + (float)i * ((15.0f - 1e-4f) / 15.0f); const float ang = (6.283185307179586f / (float)n) * tf * band;
          float fv = (lane < 16) ? cosf(ang) : -sinf(ang); if (lane == 32) fv = tf / (float)n; scr[lane] = fv; }
        asm volatile("s_waitcnt lgkmcnt(0)" ::: "memory");
        float s1 = b1v + scr[32] * w1c[0];
#pragma unroll
        for (int i = 0; i < 32; ++i) s1 += scr[i] * w1c[1 + i];
        const float h1 = sinf(f0 * s1);
        asm volatile("s_waitcnt lgkmcnt(0)" ::: "memory");
        scr[64 + lane] = h1;
        asm volatile("s_waitcnt lgkmcnt(0)" ::: "memory");
        float s2 = b2v;
#pragma unroll
        for (int i = 0; i < 64; ++i) s2 += scr[64 + i] * w2s[i * 64 + lane];
        h2buf[(size_t)(row0 + q) * 64 + lane] = sinf(f1 * s2);
        asm volatile("s_waitcnt lgkmcnt(0)" ::: "memory");
    }
}
DI void filt_item(const Args& a, const float* h2buf, bf16_t* glat, bf16_t* gctx, float* l1buf, int item, int lane) {
    const int lt = item >> 5, cgp = item & 31;
    const bool isctx = lt >= 128; const int lag0 = (isctx ? lt - 128 : lt) * 32, hrow0 = (isctx ? 4096 : 0) + lag0, n = isctx ? 256 : 4096;
    const int i32 = lane & 31, k2 = lane >> 5;
    float bv[32];
    { const float* hrow = h2buf + (size_t)(hrow0 + i32) * 64 + k2 * 32;
#pragma unroll
      for (int q = 0; q < 8; ++q) { const f32x4 v = *(const f32x4*)(hrow + 4 * q); bv[4 * q] = v[0]; bv[4 * q + 1] = v[1]; bv[4 * q + 2] = v[2]; bv[4 * q + 3] = v[3]; } }
    const int t = lag0 + i32; const float tn = (float)t / (float)n;
    const float da = -3.0701134573253944f, db = -15.350567286626972f;
    const int glen = isctx ? GCTX_LEN : GLAT_LEN;
    const float* w3 = a.in[I_HYW3]; const float* b3 = a.in[I_HYB3];
#pragma unroll 1
    for (int ct = 0; ct < 4; ++ct) {
        const int col0 = cgp * 128 + ct * 32;
        const float* wp = w3 + (size_t)(k2 * 32) * 4096 + col0 + i32;
        float av[32];
#pragma unroll
        for (int kk = 0; kk < 32; ++kk) av[kk] = wp[(size_t)kk * 4096];
        float b3v[16];
#pragma unroll
        for (int r = 0; r < 16; ++r) b3v[r] = b3[col0 + (r & 3) + 8 * (r >> 2) + 4 * k2];
        f32x16 acc;
#pragma unroll
        for (int r = 0; r < 16; ++r) acc[r] = 0.f;
#pragma unroll
        for (int kk = 0; kk < 32; ++kk) acc = __builtin_amdgcn_mfma_f32_32x32x2f32(av[kk], bv[kk], acc, 0, 0, 0);
        const int f = col0 >> 11, dir = (col0 >> 10) & 1, ch0 = col0 & 1023;
        bf16_t* gbase = isctx ? gctx + (size_t)(f * 1024 + ch0) * GCTX_LEN : glat + (size_t)(f * 1024 + ch0) * GLAT_LEN;
        const int idx = (dir == 0 ? 4223 - t : 4223 + t) - (isctx ? 3840 : 0);
        const bool store = !(dir == 1 && t == 0);
        float* l1p = l1buf + (size_t)lt * 4096 + col0;
        float vv[16], sm[16];
#pragma unroll
        for (int r = 0; r < 16; ++r) {
            const int cl = (r & 3) + 8 * (r >> 2) + 4 * k2;
            const float delta = fabsf(da + (float)(ch0 + cl) * ((db - da) / 1023.0f));
            vv[r] = (acc[r] + b3v[r]) * __expf(-tn * delta);
            sm[r] = store ? fabsf(vv[r]) : 0.f;
        }
        if (store) {
#pragma unroll
            for (int r = 0; r < 16; ++r) { const int cl = (r & 3) + 8 * (r >> 2) + 4 * k2; gbase[(size_t)cl * glen + idx] = (bf16_t)f2bf(vv[r]); }
        }
#pragma unroll
        for (int o = 1; o < 32; o <<= 1) {
            float tmp[16];
#pragma unroll
            for (int r = 0; r < 16; ++r) tmp[r] = __shfl_xor(sm[r], o);
#pragma unroll
            for (int r = 0; r < 16; ++r) sm[r] += tmp[r];
        }
        if (i32 == 0) {
#pragma unroll
            for (int r = 0; r < 16; ++r) l1p[(r & 3) + 8 * (r >> 2) + 4 * k2] = sm[r];
        }
    }
}
DI void modnorm_row(const float* xrow, const float* nw, const float* shift, const float* scale, bf16_t* orow, int lane) {
    f32x4 v[8], w[8], sh[8], sc[8]; float s = 0.f;
#pragma unroll
    for (int j = 0; j < 8; ++j) v[j] = *(const f32x4*)(xrow + 256 * j + 4 * lane);
#pragma unroll
    for (int j = 0; j < 8; ++j) { const int col = 256 * j + 4 * lane; w[j] = *(const f32x4*)(nw + col); sh[j] = *(const f32x4*)(shift + col); sc[j] = *(const f32x4*)(scale + col); }
#pragma unroll
    for (int j = 0; j < 8; ++j) s += (v[j][0] * v[j][0] + v[j][1] * v[j][1]) + (v[j][2] * v[j][2] + v[j][3] * v[j][3]);
    const float rstd = __builtin_amdgcn_rsqf(wave_sum(s) * (1.0f / DM) + EPS);
#pragma unroll
    for (int j = 0; j < 8; ++j) { const int col = 256 * j + 4 * lane;
        const f32x4 y = (v[j] * rstd) * w[j] * (sc[j] + 1.0f) + sh[j];
        u32x2 o; o.x = cvtpk(y[0], y[1]); o.y = cvtpk(y[2], y[3]);
        *(u32x2*)(orow + col) = o; }
}


typedef float cplx __attribute__((ext_vector_type(2)));
#define re x
#define im y
DI cplx cmul(cplx a, cplx b) { return (cplx){a.x * b.x - a.y * b.y, a.x * b.y + a.y * b.x}; }
DI void s5_ops_item(const Args& a, unsigned char* ws, LAS unsigned char* lds, int g) {
    const int tid = tid_opaque();
    LAS cplx* lamP = (LAS cplx*)lds;
    LAS cplx* Bb = (LAS cplx*)(lds + 17408);
    LAS cplx* Cc = (LAS cplx*)(lds + 17408 + 16384);
    LAS float* Kd = (LAS float*)(lds + 17408 + 32768);
    const float* are = a.in[I_S5ARE]; const float* aim = a.in[I_S5AIM]; const float* ldt = a.in[I_S5LOGDT];
    const float* bre = a.in[I_S5BRE]; const float* bim = a.in[I_S5BIM]; const float* cre = a.in[I_S5CRE]; const float* cim = a.in[I_S5CIM];
    __syncthreads();
    for (int e = tid; e < 2 * 17 * 64; e += NTHREADS) { const int dir = e / (17 * 64), dl = (e / 64) % 17, p = e & 63;
        const float dt = expf(ldt[dir * 64 + g]); const float ar = are[(dir * 64 + g) * 64 + p], ai = aim[(dir * 64 + g) * 64 + p];
        const float mag = expf((float)dl * dt * ar); float sn, cs; sincosf((float)dl * dt * ai, &sn, &cs);
        lamP[e] = (cplx){mag * cs, mag * sn}; }
    for (int e = tid; e < 2 * 64 * 16; e += NTHREADS) { const int dir = e / 1024, p = (e >> 4) & 63, c = e & 15;
        const float dt = expf(ldt[dir * 64 + g]); const float ar = are[(dir * 64 + g) * 64 + p], ai = aim[(dir * 64 + g) * 64 + p];
        const float mag = expf(dt * ar); float sn, cs; sincosf(dt * ai, &sn, &cs);
        const cplx lm1 = (cplx){mag * cs - 1.f, mag * sn}; const float den = ar * ar + ai * ai;
        const cplx q = (cplx){(lm1.re * ar + lm1.im * ai) / den, (lm1.im * ar - lm1.re * ai) / den};
        const size_t bi = ((size_t)(dir * 64 + g) * 64 + p) * 16 + c;
        Bb[e] = cmul(q, (cplx){bre[bi], bim[bi]}); }
    for (int e = tid; e < 2 * 16 * 64; e += NTHREADS) { const int dir = e / 1024, c = (e >> 6) & 15, p = e & 63;
        const size_t ci = ((size_t)(dir * 64 + g) * 16 + c) * 64 + p; Cc[e] = (cplx){cre[ci], cim[ci]}; }
    __syncthreads();
    for (int e = tid; e < 2 * 16 * 256; e += NTHREADS) { const int dir = e / 4096, dl = (e >> 8) & 15, co = (e >> 4) & 15, ci = e & 15;
        float acc = 0.f;
        for (int p = 0; p < 64; ++p) { const cplx t = cmul(Cc[(dir * 16 + co) * 64 + p], lamP[(dir * 17 + dl) * 64 + p]); const cplx b = Bb[(dir * 64 + p) * 16 + ci]; acc += t.re * b.re - t.im * b.im; }
        Kd[e] = acc; }
    __syncthreads();
    bf16_t* op3 = (bf16_t*)(ws + WS_OPA3) + (size_t)g * 256 * 512;
    const float* dvec = a.in[I_S5D] + g * 16;
    for (int e = tid; e < 256 * 256; e += NTHREADS) { const int row = e >> 8, kk2 = (e & 255) * 2; const int t = row >> 4, co = row & 15;
        float v[2];
#pragma unroll
        for (int q = 0; q < 2; ++q) { const int kk = kk2 + q; float val;
            if (kk < 256) { const int tau = kk >> 4, ci = kk & 15; val = 0.f;
                if (tau <= t) val += Kd[((0 * 16 + (t - tau)) * 16 + co) * 16 + ci];
                if (tau >= t) val += Kd[((1 * 16 + (tau - t)) * 16 + co) * 16 + ci];
                if (tau == t && co == ci) val += dvec[co]; }
            else { const int dir = (kk - 256) >> 7, part = ((kk - 256) >> 6) & 1, p = kk & 63;
                const cplx w = cmul(Cc[(dir * 16 + co) * 64 + p], lamP[(dir * 17 + (dir == 0 ? t + 1 : 16 - t)) * 64 + p]);
                val = part == 0 ? w.re : -w.im; }
            v[q] = val; }
        *(unsigned*)(op3 + (size_t)row * 512 + kk2) = cvtpk(v[0], v[1]); }
    bf16_t* op1 = (bf16_t*)(ws + WS_OPA1) + (size_t)g * 256 * 256;
    for (int e = tid; e < 256 * 128; e += NTHREADS) { const int row = e >> 7, kk2 = (e & 127) * 2; const int dir = row >> 7, part = (row >> 6) & 1, p = row & 63;
        float v[2];
#pragma unroll
        for (int q = 0; q < 2; ++q) { const int kk = kk2 + q, tau = kk >> 4, ci = kk & 15;
            const cplx w = cmul(lamP[(dir * 17 + (dir == 0 ? 15 - tau : tau)) * 64 + p], Bb[(dir * 64 + p) * 16 + ci]);
            v[q] = part == 0 ? w.re : w.im; }
        *(unsigned*)(op1 + (size_t)row * 256 + kk2) = cvtpk(v[0], v[1]); }
    float* lamL = (float*)(ws + WS_LAML) + (size_t)g * 256;
    for (int e = tid; e < 128; e += NTHREADS) { const int dir = e >> 6, p = e & 63; const cplx l = lamP[(dir * 17 + 16) * 64 + p]; lamL[e * 2] = l.re; lamL[e * 2 + 1] = l.im; }
    __syncthreads();
}
#undef re
#undef im
DI void s5_scan_item(unsigned char* ws, int item, int lane) {
    const int dir = item & 1, g = (item >> 1) & 63, b = item >> 7;
    const float* lamL = (const float*)(ws + WS_LAML) + (size_t)g * 256 + (dir * 64 + lane) * 2;
    const float lr = lamL[0], li = lamL[1];
    const float* E = (const float*)(ws + WS_E) + (size_t)(g * 1088 + b * 272) * 256 + dir * 128 + lane;
    bf16_t* A3 = (bf16_t*)(ws + WS_A3) + (size_t)(g * 1280 + b * 272) * 512 + 256 + dir * 128 + lane;
    float sr = 0.f, si = 0.f;
#pragma unroll 1
    for (int s0 = 0; s0 < 272; s0 += 16) {
        float er[16], ei[16]; int kcs[16];
#pragma unroll
        for (int q = 0; q < 16; ++q) { const int s = s0 + q; const int kc = dir == 0 ? s : (s < 16 ? 15 - s : 287 - s); kcs[q] = kc; er[q] = E[(size_t)kc * 256]; ei[q] = E[(size_t)kc * 256 + 64]; }
#pragma unroll
        for (int q = 0; q < 16; ++q) { bf16_t* o = A3 + (size_t)kcs[q] * 512; o[0] = (bf16_t)f2bf(sr); o[64] = (bf16_t)f2bf(si);
            const float nr = lr * sr - li * si + er[q], ni = lr * si + li * sr + ei[q]; sr = nr; si = ni; }
    }
}

constexpr int HY_UROW = 528;
constexpr int HY_JS = 36;
constexpr int HY_GRAW_OFF = 4 * HY_JS * HY_UROW;
constexpr int HY_WIN_OFF = HY_GRAW_OFF + 16960;
constexpr int HY_GRAW2_OFF = HY_WIN_OFF + 8 * 2 * 1024;
constexpr int HY_LDS = HY_GRAW2_OFF + 16960;
static_assert(HY_LDS + 128 <= LDS_BYTES - 64, "hyena LDS");
DI int crow(int r, int hi) { return (r & 3) + 8 * (r >> 2) + 4 * hi; }

DI void sconv8(const bf16_t* p, int t, int n, float w0, float w1, float w2, float bb, float (&o)[8]) {
    const u32x4 m = *(const u32x4*)p; const float um = t > 0 ? bf2f(p[-1]) : 0.f, up = t + 8 < n ? bf2f(p[8]) : 0.f;
    const float x[10] = {um, bflo(m.x), bfhi(m.x), bflo(m.y), bfhi(m.y), bflo(m.z), bfhi(m.z), bflo(m.w), bfhi(m.w), up};
#pragma unroll
    for (int i = 0; i < 8; ++i) o[i] = w0 * x[i] + w1 * x[i + 1] + w2 * x[i + 2] + bb;
}
template <bool isctx>
DI void hyena_item(const Args& a, unsigned char* ws, LAS unsigned char* lds, int item, bool do_store) {
    const int tid = tid_opaque(), lane = tid & 63, wid = __builtin_amdgcn_readfirstlane(tid >> 6);
    const int c = item & 1023;
    constexpr int NI = isctx ? 1 : 16, n = NI * 256, JJ = HY_JS, NGRP = 4 * n / 8, NITER = (NGRP + NTHREADS - 1) / NTHREADS;
    bf16_t* hpt = (bf16_t*)(ws + WS_HPT);
    const float* cw = a.in[I_HYCW]; const float* cb = a.in[I_HYCB];
    constexpr int rbase = isctx ? MLAT : 0;
    constexpr int goff = isctx ? 3840 : 0, glen = isctx ? GCTX_LEN : GLAT_LEN;
    LAS float* red = (LAS float*)(lds + HY_LDS);
    {
        const float* l1part = (const float*)(ws + WS_L1P) + (size_t)(isctx ? 128 : 0) * 4096;
        constexpr int NLT = isctx ? 8 : 128; const int lt_ = tid >> 1, dir_ = tid & 1;
        float v0_ = 0.f, v1_ = 0.f;
        if (lt_ < NLT) { v0_ = l1part[(size_t)lt_ * 4096 + dir_ * 1024 + c]; v1_ = l1part[(size_t)lt_ * 4096 + 2048 + dir_ * 1024 + c]; }
        u32x4 gq[2][3];
#pragma unroll
        for (int f = 0; f < 2; ++f) { const bf16_t* Gsrc = isctx ? (const bf16_t*)(ws + WS_GCTX) + (size_t)(f * 1024 + c) * GCTX_LEN : (const bf16_t*)(ws + WS_GLAT) + (size_t)(f * 1024 + c) * GLAT_LEN;
#pragma unroll
            for (int it = 0; it < (isctx ? 1 : 3); ++it) { const int p = tid + it * NTHREADS; if (p < glen / 8) gq[f][it] = *(const u32x4*)(Gsrc + 8 * p); } }
        for (int e = tid; e < 4 * JJ * (HY_UROW / 4); e += NTHREADS) ((LAS unsigned*)lds)[e] = 0u;
#pragma unroll
        for (int f = 0; f < 2; ++f)
#pragma unroll
            for (int it = 0; it < (isctx ? 1 : 3); ++it) { const int p = tid + it * NTHREADS; if (p < glen / 8) *(LAS u32x4*)(lds + (f == 0 ? HY_GRAW_OFF : HY_GRAW2_OFF) + 16 * p) = gq[f][it]; }
        v0_ = wave_sum(v0_); v1_ = wave_sum(v1_);
        if (lane == 0) { red[wid] = v0_; red[8 + wid] = v1_; }
    }
    __syncthreads();
    {
        const float w0 = cw[c], w1 = cw[3072 + c], w2 = cw[6144 + c], bb = cb[c];
        const bf16_t* src = hpt + (size_t)c * MTOT + rbase;
#pragma unroll
        for (int it = 0; it < NITER; ++it) { const int e = tid + it * NTHREADS;
            if (e < NGRP) { const int b = e / (n >> 3), t = 8 * (e % (n >> 3)); float o[8]; sconv8(src + b * n + t, t, n, w0, w1, w2, bb, o);
                u32x4 w; w.x = cvtpk(o[0], o[1]); w.y = cvtpk(o[2], o[3]); w.z = cvtpk(o[4], o[5]); w.w = cvtpk(o[6], o[7]);
                *(LAS u32x4*)(lds + (b * JJ + (t >> 8) + 7) * HY_UROW + (t & 255) * 2) = w; } }
    }
    __syncthreads();
    const int ip = lane & 31, hi = lane >> 5, rho = wid;
    LAS unsigned char* win = lds + HY_WIN_OFF + wid * 2048;
    const float* skip = a.in[I_HYSKIP];
    const bf16_t* sgate = hpt + (size_t)(3072 + c) * MTOT + rbase;
    const int il = ip >> 2, bt = ip & 3;
#pragma unroll 1
    for (int f = 0; f < 2; ++f) {
        const int graw = f == 0 ? HY_GRAW_OFF : HY_GRAW2_OFF;
        f32x16 acc0, acc1;
#pragma unroll
        for (int r = 0; r < 16; ++r) { acc0[r] = 0.f; acc1[r] = 0.f; }
        const int sodd = (3975 - rho - goff) & 1;
        unsigned wd[5];
#define HY_LOADW(d_) do { const int base_ = 3975 - 256 * (d_) - rho - goff; const LAS unsigned* gp_ = (const LAS unsigned*)(lds + graw) + ((base_ - sodd) >> 1) + 4 * lane; \
            wd[0] = gp_[0]; wd[1] = gp_[1]; wd[2] = gp_[2]; wd[3] = gp_[3]; wd[4] = gp_[4]; } while (0)
#define HY_STOREW(buf_) do { u32x4 w_; if (sodd) { w_.x = __builtin_amdgcn_alignbit(wd[1], wd[0], 16); w_.y = __builtin_amdgcn_alignbit(wd[2], wd[1], 16); w_.z = __builtin_amdgcn_alignbit(wd[3], wd[2], 16); w_.w = __builtin_amdgcn_alignbit(wd[4], wd[3], 16); } \
            else { w_.x = wd[0]; w_.y = wd[1]; w_.z = wd[2]; w_.w = wd[3]; } *(LAS u32x4*)(win + (buf_) * 1024 + 16 * lane) = w_; } while (0)
        int buf = 0;
        HY_LOADW(-(NI - 1)); HY_STOREW(0);
#pragma unroll 1
        for (int d = -(NI - 1); d <= NI - 1; ++d) {
            if (d < NI - 1) HY_LOADW(d + 1);
            const LAS unsigned char* wb = win + buf * 1024 + 2 * (248 - 8 * ip + 8 * hi);
            const bool val0 = (7 - d >= 0) && (0 - d <= NI - 1);
            const bool val1 = (NI > 8) && (15 - d >= 0) && (8 - d <= NI - 1);
            const LAS unsigned char* ub0 = lds + (bt * JJ + (il - d + 7)) * HY_UROW + 16 * hi;
            const LAS unsigned char* ub1 = ub0 + 8 * HY_UROW;
#pragma unroll
            for (int kh = 0; kh < 2; ++kh) {
                bf16x8 af[8], b0[8], b1[8];
#pragma unroll
                for (int k = 0; k < 8; ++k) af[k] = *(const LAS bf16x8*)(wb + 32 * (8 * kh + k));
                if (val0) {
#pragma unroll
                    for (int k = 0; k < 8; ++k) b0[k] = *(const LAS bf16x8*)(ub0 + 32 * (8 * kh + k));
                }
                if (val1) {
#pragma unroll
                    for (int k = 0; k < 8; ++k) b1[k] = *(const LAS bf16x8*)(ub1 + 32 * (8 * kh + k));
                }
                __builtin_amdgcn_sched_barrier(0);
                if (val0) {
#pragma unroll
                    for (int k = 0; k < 8; ++k) acc0 = __builtin_amdgcn_mfma_f32_32x32x16_bf16(af[k], b0[k], acc0, 0, 0, 0);
                }
                if (val1) {
#pragma unroll
                    for (int k = 0; k < 8; ++k) acc1 = __builtin_amdgcn_mfma_f32_32x32x16_bf16(af[k], b1[k], acc1, 0, 0, 0);
                }
                __builtin_amdgcn_sched_barrier(0);
            }
            if (d < NI - 1) HY_STOREW(buf ^ 1);
            buf ^= 1;
        }
#undef HY_LOADW
#undef HY_STOREW
        __syncthreads();
        const LAS float* rf = red + 8 * f;
        const float inv_l1 = 1.0f / (((rf[0] + rf[1]) + (rf[2] + rf[3])) + ((rf[4] + rf[5]) + (rf[6] + rf[7])));
        const float sk = skip[f * 1024 + c];
#pragma unroll
        for (int ib = 0; ib < 2; ++ib) {
            const int i = 8 * ib + il;
            if (i < NI) {
#pragma unroll
                for (int r = 0; r < 16; ++r) {
                    const int aa = 8 * crow(r, hi) + rho;
                    LAS bf16_t* up = (LAS bf16_t*)(lds + (bt * JJ + i + 7) * HY_UROW + aa * 2);
                    const float av = ib == 0 ? acc0[r] : acc1[r];
                    *up = (bf16_t)f2bf(av * inv_l1 + sk * bf2f(*up));
                }
            }
        }
        __syncthreads();
        {
            const int pc = (f + 1) * 1024 + c;
            const float w0 = cw[pc], w1 = cw[3072 + pc], w2 = cw[6144 + pc], bb = cb[pc];
            const bf16_t* xsrc = hpt + (size_t)pc * MTOT + rbase;
            bf16_t* ydst = hpt + (size_t)c * MTOT + rbase;
#pragma unroll
            for (int it = 0; it < NITER; ++it) { const int e = tid + it * NTHREADS;
                if (e < NGRP) { const int b = e / (n >> 3), t = 8 * (e % (n >> 3)); float o[8]; sconv8(xsrc + b * n + t, t, n, w0, w1, w2, bb, o);
                    LAS u32x4* up = (LAS u32x4*)(lds + (b * JJ + (t >> 8) + 7) * HY_UROW + (t & 255) * 2);
                    const u32x4 uw = *up;
                    const float z[8] = {o[0] * bflo(uw.x), o[1] * bfhi(uw.x), o[2] * bflo(uw.y), o[3] * bfhi(uw.y), o[4] * bflo(uw.z), o[5] * bfhi(uw.z), o[6] * bflo(uw.w), o[7] * bfhi(uw.w)};
                    if (f == 0) { u32x4 w; w.x = cvtpk(z[0], z[1]); w.y = cvtpk(z[2], z[3]); w.z = cvtpk(z[4], z[5]); w.w = cvtpk(z[6], z[7]); *up = w; }
                    else { const u32x4 hw = *(const u32x4*)(sgate + b * n + t); u32x4 w;
                        w.x = cvtpk(z[0] * siluf_(bflo(hw.x)), z[1] * siluf_(bfhi(hw.x))); w.y = cvtpk(z[2] * siluf_(bflo(hw.y)), z[3] * siluf_(bfhi(hw.y)));
                        w.z = cvtpk(z[4] * siluf_(bflo(hw.z)), z[5] * siluf_(bfhi(hw.z))); w.w = cvtpk(z[6] * siluf_(bflo(hw.w)), z[7] * siluf_(bfhi(hw.w)));
                        if (do_store) *(u32x4*)(ydst + b * n + t) = w; } } }
        }
        __syncthreads();
    }
}
DI void hy_transpose_item(unsigned char* ws, LAS unsigned char* scr, int item, int lane) {
    const int ct = item & 15, rt = item >> 4, c0 = ct * 64, R0 = rt * 64;
    const bf16_t* hpt = (const bf16_t*)(ws + WS_HPT); bf16_t* mixed = (bf16_t*)(ws + WS_MIXED);
    const int pc = lane & 7, rg = lane >> 3;
#pragma unroll
    for (int j = 0; j < 8; ++j) { const int row = 8 * j + rg; *(LAS u32x4*)(scr + row * 144 + pc * 16) = *(const u32x4*)(hpt + (size_t)(c0 + row) * MTOT + R0 + 8 * pc); }
    asm volatile("s_waitcnt lgkmcnt(0)" ::: "memory");
#pragma unroll
    for (int j = 0; j < 8; ++j) { const int R = 8 * j + rg;
        unsigned short v[8];
#pragma unroll
        for (int i = 0; i < 8; ++i) v[i] = *(const LAS unsigned short*)(scr + (8 * pc + i) * 144 + R * 2);
        u32x4 w; w.x = (unsigned)v[0] | ((unsigned)v[1] << 16); w.y = (unsigned)v[2] | ((unsigned)v[3] << 16); w.z = (unsigned)v[4] | ((unsigned)v[5] << 16); w.w = (unsigned)v[6] | ((unsigned)v[7] << 16);
        *(u32x4*)(mixed + (size_t)(R0 + R) * 2048 + c0 + 8 * pc) = w; }
    asm volatile("s_waitcnt lgkmcnt(0)" ::: "memory");
}

constexpr int AT_ROWB = 144;
constexpr int AT_KOFF = 0, AT_VOFF = 2 * 64 * AT_ROWB, AT_BUF = AT_VOFF + 128 * AT_ROWB;
constexpr int AT_LOFF = 3 * AT_BUF;
constexpr int NKV = 4352, NKT = NKV / 64;
DI void attn_unit(unsigned char* ws, LAS unsigned char* lds, int b, int h, int qb, float lam, const float* subln) {
    const int tid = tid_opaque(), lane = tid & 63, wid = __builtin_amdgcn_readfirstlane(tid >> 6);
    const int mp = wid >> 2, wq = wid & 3, i32 = lane & 31, hi = lane >> 5;
    const bf16_t* Qg = (const bf16_t*)(ws + WS_Q) + ((size_t)((b * 16 + h) * 2 + mp) * 4096 + qb * 128 + wq * 32) * 64;
    const bf16_t* Kg = (const bf16_t*)(ws + WS_K) + (size_t)((b * 16 + h) * 2) * NKV * 64;
    const bf16_t* Vg = (const bf16_t*)(ws + WS_VT) + (size_t)((b * 16 + h) * 128) * NKV;
    bf16x8 qf[4];
#pragma unroll
    for (int d0 = 0; d0 < 4; ++d0) qf[d0] = *(const bf16x8*)(Qg + i32 * 64 + d0 * 16 + hi * 8);
    const bf16_t* ksrc[2]; const bf16_t* vsrc[2]; int kdst[2], vdst[2];
#pragma unroll
    for (int j = 0; j < 2; ++j) { const int idx = tid + 512 * j;
        const int mm = idx >> 9, row = (idx >> 3) & 63, pc = idx & 7;
        ksrc[j] = Kg + ((size_t)mm * NKV + row) * 64 + pc * 8; kdst[j] = AT_KOFF + mm * 64 * AT_ROWB + row * AT_ROWB + pc * 16;
        const int e = idx >> 3;
        vsrc[j] = Vg + (size_t)e * NKV + pc * 8; vdst[j] = AT_VOFF + e * AT_ROWB + pc * 16; }
    u32x4 kr[2], vr[2];
#pragma unroll
    for (int j = 0; j < 2; ++j) { kr[j] = *(const u32x4*)ksrc[j]; vr[j] = *(const u32x4*)vsrc[j]; }
#pragma unroll
    for (int j = 0; j < 2; ++j) { *(LAS u32x4*)(lds + kdst[j]) = kr[j]; *(LAS u32x4*)(lds + vdst[j]) = vr[j]; }
#pragma unroll
    for (int j = 0; j < 2; ++j) { kr[j] = *(const u32x4*)(ksrc[j] + (size_t)64 * 64); vr[j] = *(const u32x4*)(vsrc[j] + 64); }
#pragma unroll
    for (int j = 0; j < 2; ++j) { *(LAS u32x4*)(lds + AT_BUF + kdst[j]) = kr[j]; *(LAS u32x4*)(lds + AT_BUF + vdst[j]) = vr[j]; }
    __syncthreads();
    const int pi = (i32 & 0x13) | ((i32 & 8) >> 1) | ((i32 & 4) << 1);
    const int koff = AT_KOFF + mp * 64 * AT_ROWB + pi * AT_ROWB + hi * 16;
    const int voff = AT_VOFF + i32 * AT_ROWB + hi * 16;
    f32x16 o[4];
#pragma unroll
    for (int d = 0; d < 4; ++d)
#pragma unroll
        for (int r = 0; r < 16; ++r) o[d][r] = 0.f;
    f32x16 pA[2], pB[2];
    f32x2_t ls2 = {0.f, 0.f};
    const f32x16 zero16 = {0.f, 0.f, 0.f, 0.f, 0.f, 0.f, 0.f, 0.f, 0.f, 0.f, 0.f, 0.f, 0.f, 0.f, 0.f, 0.f};
#define AT_QK(P, bufoff) do { _Pragma("unroll") for (int half = 0; half < 2; ++half) { \
        _Pragma("unroll") for (int d0 = 0; d0 < 4; ++d0) { const bf16x8 kf = *(const LAS bf16x8*)(lds + (bufoff) + koff + half * 32 * AT_ROWB + d0 * 32); \
            P[half] = __builtin_amdgcn_mfma_f32_32x32x16_bf16(kf, qf[d0], d0 == 0 ? zero16 : P[half], 0, 0, 0); } } } while (0)
#define AT_EXPH(PC, half, pa) do { \
            _Pragma("unroll") for (int r = 0; r < 16; r += 2) { PC[half][r] = __builtin_amdgcn_exp2f(PC[half][r]); PC[half][r + 1] = __builtin_amdgcn_exp2f(PC[half][r + 1]); ls2 += (f32x2_t){PC[half][r], PC[half][r + 1]}; } \
            _Pragma("unroll") for (int ks = 0; ks < 2; ++ks) { u32x4 w; w.x = cvtpk(PC[half][8 * ks], PC[half][8 * ks + 1]); w.y = cvtpk(PC[half][8 * ks + 2], PC[half][8 * ks + 3]); \
                w.z = cvtpk(PC[half][8 * ks + 4], PC[half][8 * ks + 5]); w.w = cvtpk(PC[half][8 * ks + 6], PC[half][8 * ks + 7]); pa[ks] = __builtin_bit_cast(bf16x8, w); } } while (0)
#define AT_STEP(PC, PN, t) do { \
        if ((t) + 2 < NKT) { _Pragma("unroll") for (int j = 0; j < 2; ++j) { kr[j] = *(const u32x4*)(ksrc[j] + (size_t)((t) + 2) * 64 * 64); vr[j] = *(const u32x4*)(vsrc[j] + ((t) + 2) * 64); } } \
        bf16x8 kfr[8], pa0[2], pa1[2]; \
        _Pragma("unroll") for (int q = 0; q < 8; ++q) kfr[q] = *(const LAS bf16x8*)(lds + bn + koff + (q >> 2) * 32 * AT_ROWB + (q & 3) * 32); \
        __builtin_amdgcn_sched_barrier(0); \
        AT_EXPH(PC, 0, pa0); \
        if ((t) + 1 < NKT) { _Pragma("unroll") for (int q = 0; q < 8; ++q) PN[q >> 2] = __builtin_amdgcn_mfma_f32_32x32x16_bf16(kfr[q], qf[q & 3], (q & 3) == 0 ? zero16 : PN[q >> 2], 0, 0, 0); } \
        _Pragma("unroll") for (int q = 0; q < 8; ++q) { const bf16x8 vf_ = *(const LAS bf16x8*)(lds + bc + voff + (q >> 1) * 32 * AT_ROWB + (q & 1) * 32); o[q >> 1] = __builtin_amdgcn_mfma_f32_32x32x16_bf16(pa0[q & 1], vf_, o[q >> 1], 0, 0, 0); } \
        AT_EXPH(PC, 1, pa1); \
        _Pragma("unroll") for (int q = 0; q < 8; ++q) { const bf16x8 vf_ = *(const LAS bf16x8*)(lds + bc + voff + (q >> 1) * 32 * AT_ROWB + 64 + (q & 1) * 32); o[q >> 1] = __builtin_amdgcn_mfma_f32_32x32x16_bf16(pa1[q & 1], vf_, o[q >> 1], 0, 0, 0); } \
        if ((t) + 2 < NKT) { _Pragma("unroll") for (int j = 0; j < 2; ++j) { *(LAS u32x4*)(lds + bw + kdst[j]) = kr[j]; *(LAS u32x4*)(lds + bw + vdst[j]) = vr[j]; } } \
        __syncthreads(); \
        { const int tmp_ = bc; bc = bn; bn = bw; bw = tmp_; } } while (0)
    int bc = 0, bn = AT_BUF, bw = 2 * AT_BUF;
    AT_QK(pA, 0);
#pragma unroll 1
    for (int t = 0; t < NKT; t += 2) {
        AT_STEP(pA, pB, t);
        AT_STEP(pB, pA, t + 1);
    }
    const float lsum0 = ls2[0] + ls2[1];
    float lsum = lsum0;
#undef AT_QK
#undef AT_STEP
#undef AT_EXPH
    lsum += __shfl_xor(lsum, 32);
    LAS float* ls = (LAS float*)(lds + AT_LOFF) + wid * 32;
    if (hi == 0) ls[i32] = 1.0f / lsum;
    asm volatile("s_waitcnt lgkmcnt(0)" ::: "memory");
    float rl[16];
#pragma unroll
    for (int r = 0; r < 16; ++r) rl[r] = ls[crow(r, hi)];
    LAS float* X = (LAS float*)lds + wq * 32 * 128;
    if (mp == 1) {
#pragma unroll
        for (int db = 0; db < 4; ++db)
#pragma unroll
            for (int r = 0; r < 16; ++r) X[crow(r, hi) * 128 + db * 32 + i32] = o[db][r] * rl[r] * lam;
    }
    __syncthreads();
    if (mp == 0) {
        float ss[16];
#pragma unroll
        for (int r = 0; r < 16; ++r) { float acc = 0.f;
#pragma unroll
            for (int db = 0; db < 4; ++db) { const float v = o[db][r] * rl[r] - X[crow(r, hi) * 128 + db * 32 + i32]; o[db][r] = v; acc += v * v; }
            ss[r] = acc; }
#pragma unroll
        for (int r = 0; r < 16; ++r) {
#pragma unroll
            for (int off = 1; off < 32; off <<= 1) ss[r] += __shfl_xor(ss[r], off);
            ss[r] = (1.0f - LAM_INIT) / sqrtf(ss[r] * (1.0f / 128.0f) + EPS); }
        const bf16_t* gate = (const bf16_t*)(ws + WS_GATE1); bf16_t* AO = (bf16_t*)(ws + WS_AO);
        const size_t ibase = ((size_t)b * 4096 + qb * 128 + wq * 32) * 2048 + h * 128 + i32;
        bf16_t gvv[4][16];
#pragma unroll
        for (int db = 0; db < 4; ++db)
#pragma unroll
            for (int r = 0; r < 16; ++r) gvv[db][r] = gate[ibase + (size_t)crow(r, hi) * 2048 + db * 32];
#pragma unroll
        for (int db = 0; db < 4; ++db) { const float sw = subln[db * 32 + i32];
#pragma unroll
            for (int r = 0; r < 16; ++r) AO[ibase + (size_t)crow(r, hi) * 2048 + db * 32] = (bf16_t)f2bf(o[db][r] * ss[r] * sw * bf2f(gvv[db][r])); }
    }
    __syncthreads();
}

#define XB_TMO      128
#define XB_XCNT(j)  (256  + 64 * (j))
#define XB_XSUB(j)  (1280 + 64 * (j))
#define XB_XGEN(j)  (2304 + 64 * (j))
#define XB_TOP      3328
#define XB_TOPGEN   3392
#define XCD_BAR_WORDS 3456
#define XB_SPIN_CAP (1u << 22)
DI unsigned xb_ld(unsigned* p)              { return __hip_atomic_load(p, __ATOMIC_RELAXED, __HIP_MEMORY_SCOPE_AGENT); }
DI unsigned xb_add(unsigned* p, unsigned v) { return __hip_atomic_fetch_add(p, v, __ATOMIC_RELAXED, __HIP_MEMORY_SCOPE_AGENT); }
DI unsigned xb_xcc_id() { return (unsigned)__builtin_amdgcn_s_getreg((3 << 11) | 20) & 0xFu; }
#define XB_SPIN(cond, bar) do { unsigned _sp = 0; while (cond) { __builtin_amdgcn_s_sleep(1); \
    if ((++_sp & 255u) == 0u) { if (xb_ld(&(bar)[XB_TMO])) break; if (_sp > XB_SPIN_CAP) { atomicAdd(&(bar)[XB_TMO], 1u); break; } } } } while (0)
struct XcdBarrier { unsigned* bar; unsigned x; volatile LAS unsigned* st; };
DI XcdBarrier xcd_barrier_post(unsigned* bar, volatile LAS unsigned* st) {
    XcdBarrier b; b.bar = bar; b.x = xb_xcc_id(); b.st = st;
    if (threadIdx.x == 0) (void)xb_add(&bar[XB_XCNT(b.x)], 1u);
    return b;
}
DI void xcd_barrier_complete(unsigned* bar, unsigned x, unsigned& nloc, unsigned& nx) {
    const unsigned G = gridDim.x * gridDim.y * gridDim.z;
    unsigned sum, cnt, mine, sp = 0u;
    for (;;) {
        sum = 0u; cnt = 0u; mine = 0u;
#pragma unroll
        for (unsigned j = 0; j < 16; ++j) { const unsigned c = xb_ld(&bar[XB_XCNT(j)]); sum += c; cnt += (c > 0u) ? 1u : 0u; mine = (j == x) ? c : mine; }
        if (sum == G) break;
        __builtin_amdgcn_s_sleep(1);
        if ((++sp & 255u) == 0u) { if (xb_ld(&bar[XB_TMO])) break; if (sp > XB_SPIN_CAP) { atomicAdd(&bar[XB_TMO], 1u); break; } }
    }
    nloc = mine > 0u ? mine : 1u; nx = cnt > 0u ? cnt : 1u;
}
DI void xcd_barrier(const XcdBarrier& b) {
    asm volatile("s_waitcnt vmcnt(0)" ::: "memory");
    __syncthreads();
    if (threadIdx.x == 0) {
        unsigned* bar = b.bar;
        __builtin_amdgcn_s_waitcnt(0);
        unsigned nloc = b.st[0], nx = b.st[1];
        if (nloc == 0u) { xcd_barrier_complete(bar, b.x, nloc, nx); b.st[0] = nloc; b.st[1] = nx; }
        const unsigned old = xb_add(&bar[XB_XSUB(b.x)], 1u);
        const unsigned gen = old / nloc;
        if (old + 1u == (gen + 1u) * nloc) {
            __builtin_amdgcn_fence(__ATOMIC_RELEASE, "agent");
            asm volatile("s_waitcnt vmcnt(0)" ::: "memory");
            const unsigned og = xb_add(&bar[XB_TOP], 1u);
            const unsigned tg = og / nx;
            if (og + 1u == (tg + 1u) * nx) xb_add(&bar[XB_TOPGEN], 1u);
            else XB_SPIN(xb_ld(&bar[XB_TOPGEN]) == tg, bar);
            __builtin_amdgcn_fence(__ATOMIC_ACQUIRE, "agent");
            xb_add(&bar[XB_XGEN(b.x)], 1u);
            asm volatile("s_waitcnt vmcnt(0)" ::: "memory");
        } else {
            XB_SPIN(xb_ld(&bar[XB_XGEN(b.x)]) == gen, bar);
            __builtin_amdgcn_fence(__ATOMIC_ACQUIRE, "agent");
            asm volatile("s_waitcnt vmcnt(0)" ::: "memory");
        }
    }
    __syncthreads();
}

__global__ void __launch_bounds__(NTHREADS, 2) fwd_kernel(Args a) {
    extern __shared__ __attribute__((aligned(16))) unsigned char lds_raw[];
    LAS unsigned char* lds = (LAS unsigned char*)lds_raw;
    cg::grid_group grid = cg::this_grid();
    const int G = gridDim.x, bid = blockIdx.x;
#define PHASE_IDS const int tid = tid_opaque(), lane = tid & 63, wid = __builtin_amdgcn_readfirstlane(tid >> 6), gw = bid * NWAVES + wid, NGW = G * NWAVES; (void)tid; (void)lane; (void)gw; (void)NGW;
    unsigned char* ws = a.ws;
    volatile LAS unsigned* bst = (volatile LAS unsigned*)(lds + LDS_BYTES - 64);
    if (threadIdx.x < 16) bst[threadIdx.x] = 0u;
    __syncthreads();
    const XcdBarrier xbar = xcd_barrier_post((unsigned*)(ws + OFF_BAR), bst);
#define GRID_BAR() xcd_barrier(xbar)
    float* mod = (float*)(ws + OFF_MOD);
    bf16_t* HN = (bf16_t*)(ws + WS_HN);

#ifndef SKIP_P0
    for (int g = G - 1 - bid; g < 64; g += G) s5_ops_item(a, ws, lds, g);
    __syncthreads();
    {
        PHASE_IDS
        LAS float* scr = (LAS float*)(lds + wid * 8704);
        LAS float* w2s = (LAS float*)(lds + 69632);
        { const float* w2 = a.in[I_HYW2]; for (int e = tid; e < 4096; e += NTHREADS) w2s[e] = w2[e]; }
        __syncthreads();
        constexpr int I_A = (2048 / 64) * (6144 / 32), I_B = (2048 / 64) * (2048 / 32), I_C2 = (1024 / 64) * (1024 / 32), I_M = 2 * 24 * 32, I_H = 544;
                if (gw == NGW - 1) { float* rp = (float*)(ws + WS_ROPE); for (int e = lane; e < 1024; e += 64) { const int pos = e >> 4, i = e & 15; const float fr_ = expf(-(float)i * (9.210340371976184f / 16.0f)); float sn, cs; sincosf((float)pos * fr_, &sn, &cs); rp[pos * 32 + i] = cs; rp[pos * 32 + 16 + i] = sn; } }
        for (int it = gw; it < I_M; it += NGW) mod_item(a, mod, scr, it, lane);
        for (int it = gw; it < I_H; it += NGW) h2_item(a, (float*)(ws + WS_H2), scr, w2s, I_H - 1 - it, lane);
        constexpr int NTR = I_A + I_B + I_C2;
        const int NTW = (G > 128 ? G - 64 : G) * NWAVES;
        for (int it = gw; it < NTR && gw < NTW; it += NTW) {
            int r = it;
            if (r < I_A) { transpose_item<false>(a.in[I_EVIN], 2048, 6144, (bf16_t*)(ws + WS_EVIN_T), scr, r, lane); continue; } r -= I_A;
            if (r < I_B) { transpose_item<false>(a.in[I_EVOUT], 2048, 2048, (bf16_t*)(ws + WS_EVOUT_T), scr, r, lane); continue; } r -= I_B;
            transpose_item<false>(a.in[I_GLUW], 1024, 1024, (bf16_t*)(ws + WS_GLU_T), scr, r, lane);
        }

    }
#endif
    grid.sync();
#ifndef SKIP_P1
    {
        PHASE_IDS
        {
            bf16_t* glat = (bf16_t*)(ws + WS_GLAT); bf16_t* gctx = (bf16_t*)(ws + WS_GCTX);
            const int gt = bid * NTHREADS + tid, GT = G * NTHREADS;
            for (int e = gt; e < 2048 * 258; e += GT) { const int fc = e / 258, q = e % 258; const int idx = q < 128 ? q : 8319 + (q - 128); if (idx < GLAT_LEN) glat[(size_t)fc * GLAT_LEN + idx] = 0; }
            for (int e = gt; e < 2048 * 258; e += GT) { const int fc = e / 258, q = e % 258; const int idx = q < 128 ? q : 639 + (q - 128); if (idx < GCTX_LEN) gctx[(size_t)fc * GCTX_LEN + idx] = 0; }
        }
        constexpr int NF = 136 * 32;
        for (int it = gw; it < NF; it += NGW) filt_item(a, (const float*)(ws + WS_H2), (bf16_t*)(ws + WS_GLAT), (bf16_t*)(ws + WS_GCTX), (float*)(ws + WS_L1P), it, lane);
        const float* nw = a.in[I_NORMW];
        for (int rep = 0; rep < REP_P1M; ++rep)
        for (int R = gw; R < MTOT; R += NGW) {
            const bool lat = R < MLAT; const int mrow = lat ? (R >> 12) : 4;
            const float* xr = lat ? a.in[I_X] + (size_t)R * DM : a.in[I_CTX] + (size_t)(R - MLAT) * DM;
            modnorm_row(xr, nw, mod + mrow * 6144, mod + mrow * 6144 + 2048, HN + (size_t)R * DM, lane);
        }
    }
#endif
    GRID_BAR();
#ifndef SKIP_P2
    {
        const bf16_t* WT = (const bf16_t*)(ws + WS_EVIN_T);
        { pg8::Gemm g{WT, HN, 2048, 2048, 2048, HN, WT + (size_t)4096 * 2048, nullptr, nullptr};
          P2Order S; S.S0.init(4096, MTOT, G, bid); S.S1.init(MTOT, 2048, G, bid); S.G = G; S.c = bid;
          EpiP2 E{EpiStoreBf16{(bf16_t*)(ws + WS_HPT), MTOT}, EpiProjBP{(bf16_t*)(ws + WS_A3), (bf16_t*)(ws + WS_SG)}};
          pg8::gemm_phase<EpiP2, P2Order>(lds, g, S, E); }
    }
#endif
    GRID_BAR();
#ifndef SKIP_P3
    {
#ifndef SKIP_S5A
        { pg8::Gemm g{(const bf16_t*)(ws + WS_A3), (const bf16_t*)(ws + WS_OPA1), 512, 256, 256}; pg8::S5Order S{G, bid};
          EpiS5E E{(float*)(ws + WS_E)};
          pg8::gemm_phase<EpiS5E, pg8::S5Order>(lds, g, S, E); }
#endif
        for (int rep = 0; rep < REP_HY; ++rep) {
        for (int it = bid; it < 1024; it += G) hyena_item<false>(a, ws, lds, it, rep == REP_HY - 1);
        for (int it = bid; it < 1024; it += G) hyena_item<true>(a, ws, lds, 1024 + it, rep == REP_HY - 1); }
    }
#endif
    GRID_BAR();
#ifndef SKIP_S5B
    for (int rep = 0; rep < REP_P3B; ++rep)
    { PHASE_IDS for (int it = gw; it < 512; it += NGW) s5_scan_item(ws, it, lane);
      LAS unsigned char* scr = lds + wid * 9216;
      for (int it = NGW - 1 - gw; it < 4352; it += NGW) hy_transpose_item(ws, scr, it, lane);
      { constexpr int I_A = (2048 / 64) * (8192 / 32), I_B = (2048 / 64) * (2048 / 32);
        const int nscan = NGW > 1024 ? 512 : 0;
        if (gw >= nscan) for (int it = gw - nscan; it < I_A + I_B; it += NGW - nscan) {
            if (it < I_A) transpose_item<true>(a.in[I_ODIN], 2048, 8192, (bf16_t*)(ws + WS_ODIN_T), (LAS float*)scr, it, lane);
            else transpose_item<false>(a.in[I_ODOUT], 2048, 2048, (bf16_t*)(ws + WS_ODOUT_T), (LAS float*)scr, it - I_A, lane); } } }
#endif
    GRID_BAR();
#ifndef SKIP_S5C
    { pg8::Gemm g{(const bf16_t*)(ws + WS_A3), (const bf16_t*)(ws + WS_OPA3), 512, 512, 512}; pg8::S5Order S{G, bid};
      EpiS5Y E{(bf16_t*)(ws + WS_GB)};
      pg8::gemm_phase<EpiS5Y, pg8::S5Order>(lds, g, S, E); }
#endif
    GRID_BAR();
#ifndef SKIP_P4
    { pg8::Gemm g{(const bf16_t*)(ws + WS_GB), (const bf16_t*)(ws + WS_GLU_T), 1024, 1024, 1024}; pg8::StaticOrder S; S.init(MTOT, 1024, G, bid);
      EpiGlu E{(const bf16_t*)(ws + WS_GB), (const bf16_t*)(ws + WS_SG), a.in[I_GLUB], (bf16_t*)(ws + WS_MIXED)};
      pg8::gemm_phase<EpiGlu, pg8::StaticOrder>(lds, g, S, E); }
#endif
    GRID_BAR();
#ifndef SKIP_P5
    for (int rep = 0; rep < REP_P57; ++rep)
    {
        pg8::Gemm g{(const bf16_t*)(ws + WS_MIXED), (const bf16_t*)(ws + WS_EVOUT_T), 2048, 2048, 2048}; pg8::StaticOrder S; S.init(MTOT, 2048, G, bid);
        EpiOut0 E{a.in[I_X], a.in[I_CTX], mod, a.out, (float*)(ws + WS_CTX1)};
        pg8::gemm_phase<EpiOut0, pg8::StaticOrder>(lds, g, S, E);
    }
#endif
    GRID_BAR();
    for (int rep = 0; rep < REP_P6; ++rep)
    {
        PHASE_IDS
        LAS float* scr = (LAS float*)(lds + wid * 16768);
        const float* nw = a.in[I_NORMW] + DM; const float* mod1 = mod + 5 * 6144;
        for (int R = gw; R < MTOT; R += NGW) {
            const bool lat = R < MLAT; const int mrow = lat ? (R >> 12) : 4;
            const float* xr = lat ? a.out + (size_t)R * DM : (const float*)(ws + WS_CTX1) + (size_t)(R - MLAT) * DM;
            modnorm_row(xr, nw, mod1 + mrow * 6144, mod1 + mrow * 6144 + 2048, HN + (size_t)R * DM, lane);
        }
    }
    GRID_BAR();
    for (int rep = 0; rep < REP_P57; ++rep)
    {
        const bf16_t* WT = (const bf16_t*)(ws + WS_ODIN_T);
        const float* rope = (const float*)(ws + WS_ROPE);
        { pg8::Gemm g{HN, WT, 2048, 2048, 2048, HN + (size_t)MLAT * 2048, WT + (size_t)2048 * 2048, WT + (size_t)4096 * 2048, HN};
          P7Order S; S.Sa.init(MLAT, 24 * 256, G, bid); S.Sb.init(MCTX, 2048, G, bid); S.Sc.init(2048, MTOT, G, bid); S.G = G; S.c = bid;
          EpiQKG Ea{(bf16_t*)(ws + WS_Q), (bf16_t*)(ws + WS_K), (bf16_t*)(ws + WS_GATE1), a.in[I_QNORM], a.in[I_KNORM], rope, 0, 0};
          EpiP7 E{Ea, EpiVT{(bf16_t*)(ws + WS_VT)}};
          pg8::gemm_phase<EpiP7, P7Order>(lds, g, S, E); }
    }
    GRID_BAR();
    for (int rep = 0; rep < EXTRA_SYNC; ++rep) GRID_BAR();
    {
        float d1 = 0.f, d2 = 0.f;
        { const float* q1 = a.in[I_LQ1]; const float* k1 = a.in[I_LK1]; const float* q2 = a.in[I_LQ2]; const float* k2 = a.in[I_LK2];
          for (int i = 0; i < 64; ++i) { d1 += q1[i] * k1[i]; d2 += q2[i] * k2[i]; } }
        const float lam = expf(d1) - expf(d2) + LAM_INIT;
        for (int rep = 0; rep < REP_ATTN; ++rep)
        for (int u = bid; u < 2048; u += G) attn_unit(ws, lds, u >> 9, (u >> 5) & 15, u & 31, lam, a.in[I_SUBLN]);
    }
    GRID_BAR();
    {
        pg8::Gemm g{(const bf16_t*)(ws + WS_AO), (const bf16_t*)(ws + WS_ODOUT_T), 2048, 2048, 2048}; pg8::StaticOrder S; S.init(MLAT, 2048, G, bid);
        EpiOut1 E{mod + 5 * 6144, a.out};
        pg8::gemm_phase<EpiOut1, pg8::StaticOrder>(lds, g, S, E);
    }
}


extern "C" void kernel_launch(void* const* d_in, const int* in_sizes, int n_in, void* d_out, int out_size, void* d_ws, size_t ws_size, hipStream_t stream) {
    static int grid = 0;
    if (grid == 0) {
        int dev = 0, cus = 0, per_cu = 0;
        hipGetDevice(&dev);
        hipDeviceGetAttribute(&cus, hipDeviceAttributeMultiprocessorCount, dev);
        hipFuncSetAttribute((const void*)fwd_kernel, hipFuncAttributeMaxDynamicSharedMemorySize, LDS_BYTES);
        hipOccupancyMaxActiveBlocksPerMultiprocessor(&per_cu, (const void*)fwd_kernel, NTHREADS, LDS_BYTES);
        (void)hipGetLastError();
        grid = cus;
        if (ws_size < WS_NEED) { fprintf(stderr, "kernel_launch: workspace too small: %zu < %zu\n", ws_size, (size_t)WS_NEED); grid = -1; }
    }
    if (grid < 0) return;
    hipMemsetAsync((char*)d_ws + WS_CTL, 0, CTL_ZERO_BYTES, stream);
    Args a{};
    for (int i = 0; i < 38 && i < n_in; ++i) a.in[i] = (const float*)d_in[i];
    a.out = (float*)d_out; a.ws = (unsigned char*)d_ws;
    void* args[] = {&a};
    hipError_t e = hipLaunchCooperativeKernel((const void*)fwd_kernel, dim3(grid), dim3(NTHREADS), args, LDS_BYTES, stream);
    if (e != hipSuccess) fprintf(stderr, "cooperative launch failed: %s\n", hipGetErrorString(e));
}
```

```cpp
#include <hip/hip_runtime.h>
#include <hip/hip_cooperative_groups.h>
#include <cstdio>
#include <cstdint>
#include <cmath>
namespace cg = cooperative_groups;

#define LAS __attribute__((address_space(3)))
#define DI __device__ __forceinline__
typedef unsigned short bf16_t;
typedef short bf16x8 __attribute__((ext_vector_type(8)));
typedef float f32x4 __attribute__((ext_vector_type(4)));
typedef float f32x16 __attribute__((ext_vector_type(16)));
typedef unsigned u32x4 __attribute__((ext_vector_type(4)));
typedef unsigned u32x2 __attribute__((ext_vector_type(2)));
typedef float f32x2_t __attribute__((ext_vector_type(2)));
typedef __bf16 bf16x2_t __attribute__((ext_vector_type(2)));

DI unsigned cvtpk(float lo, float hi) { f32x2_t v = {lo, hi}; bf16x2_t b = __builtin_convertvector(v, bf16x2_t); return __builtin_bit_cast(unsigned, b); }
DI unsigned f2bf(float f) { return cvtpk(f, 0.f) & 0xffffu; }
DI float bf2f(unsigned short h) { return __uint_as_float(((unsigned)h) << 16); }
DI float bflo(unsigned w) { return __uint_as_float(w << 16); }
DI float bfhi(unsigned w) { return __uint_as_float(w & 0xffff0000u); }
DI float sigmoidf_(float x) { return __builtin_amdgcn_rcpf(1.f + __expf(-x)); }
DI float siluf_(float x) { return x * __builtin_amdgcn_rcpf(1.f + __expf(-x)); }
DI float gelu_tanh(float x) { const float u = 0.7978845608028654f * (x + 0.044715f * x * x * x); const float t = 1.f - 2.f * __builtin_amdgcn_rcpf(1.f + __expf(2.f * u)); return 0.5f * x * (1.f + t); }
DI int tid_opaque() { int t = threadIdx.x; asm volatile("" : "+v"(t)); return t; }
DI float wave_sum(float v) {
#pragma unroll
    for (int o = 1; o < 64; o <<= 1) v += __shfl_xor(v, o);
    return v;
}

constexpr int DM = 2048, NB = 4, SEQ = 4096, CTXL = 256;
constexpr int MLAT = NB * SEQ;
constexpr int MCTX = NB * CTXL;
constexpr int MTOT = MLAT + MCTX;
constexpr int EVEN_IN = 6144, ODD_IN = 8192;
constexpr float EPS = 1e-6f;
constexpr int NTHREADS = 512, NWAVES = 8;
constexpr int LDS_BYTES = 147456;
constexpr int REP_ATTN = 1, REP_HY = 1, REP_P1M = 1, REP_P3B = 1, REP_P6 = 1, REP_P57 = 1, REP_P2 = 1, EXTRA_SYNC = 0;

constexpr size_t MiB = 1u << 20;
constexpr size_t WS_CTL = 0;
constexpr size_t CTL_ZERO_BYTES = 1 * MiB;
constexpr size_t OFF_MOD = 4096;
constexpr size_t OFF_L1 = 512 * 1024;
constexpr size_t OFF_BAR = 600 * 1024;
constexpr size_t WS_EVIN_T = 1 * MiB;
constexpr size_t WS_EVOUT_T = WS_EVIN_T + (size_t)6144 * 2048 * 2;
constexpr size_t WS_GLU_T = WS_EVOUT_T + (size_t)2048 * 2048 * 2;
constexpr size_t WS_H2 = WS_GLU_T + (size_t)1024 * 1024 * 2;
constexpr size_t WS_ROPE = WS_H2 + (size_t)4352 * 64 * 4;
constexpr size_t WS_LAML = WS_ROPE + 8192;
constexpr size_t WS_L1P = WS_LAML + 64 * 1024;
static_assert(WS_L1P + 136 * 4096 * 4 <= 40 * MiB, "ws map");
constexpr size_t WS_REGION2 = 40 * MiB;
constexpr int GLAT_LEN = 8448, GCTX_LEN = 768;
constexpr size_t WS_GLAT = WS_REGION2;
constexpr size_t WS_GCTX = WS_GLAT + (size_t)2 * 1024 * GLAT_LEN * 2;
constexpr size_t WS_OPA1 = WS_GCTX + (size_t)2 * 1024 * GCTX_LEN * 2;
constexpr size_t WS_OPA3 = WS_OPA1 + (size_t)64 * 256 * 256 * 2;
constexpr size_t WS_REGION2_END = WS_OPA3 + (size_t)64 * 256 * 512 * 2;
constexpr size_t WS_ODIN_T = WS_REGION2;
constexpr size_t WS_ODOUT_T = WS_ODIN_T + (size_t)8192 * 2048 * 2;
static_assert(WS_ODOUT_T + (size_t)2048 * 2048 * 2 <= WS_REGION2_END, "region2 overlay");
constexpr size_t WS_CTX1 = 104 * MiB;
constexpr size_t WS_HN = 112 * MiB;
static_assert(WS_REGION2_END <= WS_CTX1, "ws map");
constexpr size_t WS_E = WS_HN;
constexpr size_t WS_HPT = WS_HN + (size_t)MTOT * 2048 * 2;
constexpr size_t WS_SG = WS_HPT + (size_t)4096 * MTOT * 2;
constexpr size_t WS_A3 = WS_SG + (size_t)MTOT * 1024 * 2;
constexpr size_t WS_MIXED = WS_A3 + (size_t)64 * 1280 * 512 * 2;
constexpr size_t WS_GB = WS_HN;
constexpr size_t WS_L0_END = WS_MIXED + (size_t)MTOT * 2048 * 2;
constexpr size_t WS_Q = WS_HPT;
constexpr size_t WS_K = WS_Q + (size_t)4 * 16 * 2 * 4096 * 64 * 2;
constexpr size_t WS_VT = WS_K + (size_t)4 * 16 * 2 * 4352 * 64 * 2;
constexpr size_t WS_GATE1 = WS_VT + (size_t)4 * 16 * 128 * 4352 * 2;
constexpr size_t WS_AO = WS_GATE1 + (size_t)MLAT * 2048 * 2;
constexpr size_t WS_L1_END = WS_AO + (size_t)MLAT * 2048 * 2;
constexpr size_t WS_NEED = (WS_L0_END > WS_L1_END ? WS_L0_END : WS_L1_END);
static_assert(WS_NEED <= (size_t)536870912, "ws budget");

namespace pg8 {
constexpr int BM = 256, BK = 64, HALF = 128, HTB = HALF * BK * 2, STAGE_BYTES = 8 * HTB, NXCD = 8, WGM = 8;
__host__ __device__ __forceinline__ int lds_byte(int r, int c) { const int st = (r >> 4) * 2 + (c >> 5), rr = r & 15, cc = c & 31, ob = rr * 64 + cc * 2; return st * 1024 + (ob ^ (((ob >> 9) & 1) << 5)); }
__host__ __device__ __forceinline__ void stage_rc(int b, int& R, int& C) { const int st = b / 1024, sb = b % 1024, swz = sb ^ (((sb >> 9) & 1) << 5); R = (st >> 1) * 16 + swz / 64; C = (st & 1) * 32 + (swz % 64) / 2; }
__host__ __device__ __forceinline__ int perm32(int rho) { const int n = rho >> 4, i = rho & 15; return 8 * (i >> 2) + 4 * n + (i & 3); }

struct Unit { int pm, pn, kind; };
struct Gemm { const bf16_t* A; const bf16_t* Bt; int lda, ldb, K; const bf16_t* A1; const bf16_t* Bt1; const bf16_t* A2; const bf16_t* Bt2; };

struct StaticOrder {
    int nM, nN, nwg, G, c;
    __device__ void init(int M, int N, int G_, int c_) { nM = M / BM; nN = N / BM; nwg = nM * nN; G = G_; c = c_; }
    __device__ bool next(int i, Unit& u) const { return map((long)i * G + c, u); }
    __device__ bool map(long L, Unit& u) const {
        if (L >= nwg) return false; u.kind = 0;
        int wgid = (int)L; { const int q = nwg / NXCD, r = nwg % NXCD, xcd = wgid % NXCD, off = wgid / NXCD; wgid = (xcd < r ? xcd * (q + 1) : r * (q + 1) + (xcd - r) * q) + off; }
        const int nig = WGM * nN, gid = wgid / nig, fm = gid * WGM, gsz = (nM - fm) < WGM ? (nM - fm) : WGM;
        u.pm = fm + ((wgid % nig) % gsz); u.pn = (wgid % nig) / gsz; return true;
    }
};
struct S5Order {
    int G, c;
    __device__ bool next(int i, Unit& u) const { const int L = i * G + c; if (L >= 320) return false; const int g = L / 5, t = L % 5; u.pm = g * 5 + t; u.pn = g; u.kind = 0; return true; }
};

template <class Epi, class Sched>
__device__ __forceinline__ void gemm_phase(LAS unsigned char* lds, const Gemm g, const Sched& S, const Epi& E) {
    const int tid = tid_opaque(), wid = __builtin_amdgcn_readfirstlane(tid >> 6), lane = tid & 63, wr = wid >> 2, wc = wid & 3, fr = lane & 15, fq = lane >> 4;
    const int K = g.K, nt = K / BK;
    unsigned voffA[2], voffB[2];
#pragma unroll
    for (int i = 0; i < 2; ++i) { int R, C; stage_rc(tid * 16 + i * 8192, R, C); const int Rb = Epi::PERM ? ((R & ~31) + perm32(R & 31)) : R;
        voffA[i] = (unsigned)(R * g.lda + C) * 2u; voffB[i] = (unsigned)(Rb * g.ldb + C) * 2u; }
    const size_t kstep = (size_t)(BK * 2);
    const size_t hstepA = (size_t)HALF * g.lda * 2, hstepB = (size_t)HALF * g.ldb * 2;
    const size_t tstepA = 2 * hstepA, tstepB = 2 * hstepB;
    const unsigned ldsw = (unsigned)wid * 1024u;
    const int aoff = lds_byte(wr * 64 + fr, fq * 8), boff = lds_byte(wc * 32 + fr, fq * 8);
#define PG8_SA(b, h) (((b) * 2 + (h)) * HTB)
#define PG8_SB(b, h) ((4 + (b) * 2 + (h)) * HTB)
#define PG8_STAGE(bufoff, gbase, voff) do { _Pragma("unroll") for (int _i = 0; _i < 2; ++_i) \
        __builtin_amdgcn_global_load_lds((const unsigned*)((const char*)(gbase) + (voff)[_i]), (LAS unsigned*)(lds + (bufoff) + ldsw + _i * 8192), 16, 0, 0); } while (0)
#define PG8_LDA(dst, b, h) do { _Pragma("unroll") for (int m = 0; m < 4; ++m) _Pragma("unroll") for (int k = 0; k < 2; ++k) dst[m][k] = *(const LAS bf16x8*)(lds + PG8_SA(b, h) + aoff + m * 2048 + k * 1024); } while (0)
#define PG8_LDB(dst, b, h) do { _Pragma("unroll") for (int n = 0; n < 2; ++n) _Pragma("unroll") for (int k = 0; k < 2; ++k) dst[n][k] = *(const LAS bf16x8*)(lds + PG8_SB(b, h) + boff + n * 2048 + k * 1024); } while (0)
#define PG8_MMA(ai, bj, At, Bt) do { __builtin_amdgcn_s_setprio(1); _Pragma("unroll") for (int m = 0; m < 4; ++m) _Pragma("unroll") for (int n = 0; n < 2; ++n) _Pragma("unroll") for (int k = 0; k < 2; ++k) \
        acc[ai][bj][m][n] = __builtin_amdgcn_mfma_f32_16x16x32_bf16(Bt[n][k], At[m][k], acc[ai][bj][m][n], 0, 0, 0); __builtin_amdgcn_s_setprio(0); } while (0)
#define PG8_WAIT_V(n) asm volatile("s_waitcnt vmcnt(" #n ")" ::: "memory")
#define PG8_WAIT_L(n) asm volatile("s_waitcnt lgkmcnt(" #n ")" ::: "memory")
#define PG8_BAR __builtin_amdgcn_s_barrier()
#define PG8_SCHED __builtin_amdgcn_sched_barrier(0)
    Unit cur, nxt; int ui = 0;
    if (!S.next(0, cur)) return;
    f32x4 acc[2][2][4][2];
#pragma unroll
    for (int a = 0; a < 2; ++a)
#pragma unroll
        for (int b = 0; b < 2; ++b)
#pragma unroll
            for (int m = 0; m < 4; ++m)
#pragma unroll
                for (int n = 0; n < 2; ++n) acc[a][b][m][n] = (f32x4){0.f, 0.f, 0.f, 0.f};
    bf16x8 At[4][2], B0[2][2], B1[2][2];
#define PG8_ABASE(u) ((const char*)((u).kind == 0 ? g.A : ((u).kind == 1 ? g.A1 : g.A2)) + (size_t)(u).pm * tstepA)
#define PG8_BBASE(u) ((const char*)((u).kind == 0 ? g.Bt : ((u).kind == 1 ? g.Bt1 : g.Bt2)) + (size_t)(u).pn * tstepB)
    const char* cA = PG8_ABASE(cur); const char* cB = PG8_BBASE(cur);
    PG8_STAGE(PG8_SB(0, 0), cB, voffB); PG8_STAGE(PG8_SB(0, 1), cB + hstepB, voffB); PG8_STAGE(PG8_SA(0, 0), cA, voffA); PG8_STAGE(PG8_SA(0, 1), cA + hstepA, voffA);
    if (wr == 1) PG8_BAR;
    PG8_WAIT_V(2); PG8_BAR;
    PG8_STAGE(PG8_SB(1, 0), cB + kstep, voffB); PG8_STAGE(PG8_SA(1, 0), cA + kstep, voffA); PG8_STAGE(PG8_SB(1, 1), cB + hstepB + kstep, voffB);
    PG8_WAIT_V(6); PG8_BAR;
    for (;;) {
        const bool has_next = S.next(ui + 1, nxt);
        const char* nA = has_next ? PG8_ABASE(nxt) : cA; const char* nB = has_next ? PG8_BBASE(nxt) : cB;
        for (int t = 0; t < nt; t += 2) {
            const bool last = (t == nt - 2);
            const char* a1 = cA + (size_t)(t + 1) * kstep;
            const char* a2 = last ? nA : cA + (size_t)(t + 2) * kstep; const char* b2 = last ? nB : cB + (size_t)(t + 2) * kstep;
            const char* a3 = a2 + kstep; const char* b3 = b2 + kstep;
            PG8_LDB(B0, 0, 0); PG8_LDB(B1, 0, 1); PG8_SCHED; PG8_LDA(At, 0, 0); PG8_STAGE(PG8_SA(1, 1), a1 + hstepA, voffA);
            PG8_WAIT_V(8); PG8_WAIT_L(0); PG8_BAR; PG8_MMA(0, 0, At, B0); PG8_MMA(0, 1, At, B1); PG8_BAR; PG8_SCHED;
            PG8_LDA(At, 0, 1); PG8_STAGE(PG8_SB(0, 0), b2, voffB); PG8_STAGE(PG8_SB(0, 1), b2 + hstepB, voffB); PG8_STAGE(PG8_SA(0, 0), a2, voffA);
            PG8_WAIT_V(8); PG8_WAIT_L(0); PG8_BAR; PG8_MMA(1, 0, At, B0); PG8_MMA(1, 1, At, B1); PG8_BAR; PG8_SCHED;
            PG8_LDB(B0, 1, 0); PG8_LDB(B1, 1, 1); PG8_SCHED; PG8_LDA(At, 1, 0); PG8_STAGE(PG8_SA(0, 1), a2 + hstepA, voffA);
            PG8_WAIT_V(8); PG8_WAIT_L(0); PG8_BAR; PG8_MMA(0, 0, At, B0); PG8_MMA(0, 1, At, B1); PG8_BAR; PG8_SCHED;
            PG8_LDA(At, 1, 1); PG8_STAGE(PG8_SB(1, 0), b3, voffB); PG8_STAGE(PG8_SB(1, 1), b3 + hstepB, voffB); PG8_STAGE(PG8_SA(1, 0), a3, voffA);
            PG8_WAIT_V(8); PG8_WAIT_L(0); PG8_BAR; PG8_MMA(1, 0, At, B0); PG8_MMA(1, 1, At, B1); PG8_BAR; PG8_SCHED;
        }
        if (wr == 0) PG8_BAR;
        E(acc, cur, wr, wc, fr, fq);
        if (!has_next) break;
#pragma unroll
        for (int a = 0; a < 2; ++a)
#pragma unroll
            for (int b = 0; b < 2; ++b)
#pragma unroll
                for (int m = 0; m < 4; ++m)
#pragma unroll
                    for (int n = 0; n < 2; ++n) acc[a][b][m][n] = (f32x4){0.f, 0.f, 0.f, 0.f};
        cur = nxt; cA = nA; cB = nB; ++ui;
        if (wr == 1) PG8_BAR;
    }
    PG8_WAIT_V(0);
    PG8_BAR;
#undef PG8_ABASE
#undef PG8_BBASE
#undef PG8_SA
#undef PG8_SB
#undef PG8_STAGE
#undef PG8_LDA
#undef PG8_LDB
#undef PG8_MMA
#undef PG8_WAIT_V
#undef PG8_WAIT_L
#undef PG8_BAR
#undef PG8_SCHED
}
}
using pg8::Unit;
typedef f32x4 AccT[2][2][4][2];

DI void row_to_chunk(int R, int& n, int& tau) {
    if (R < MLAT) { const int b = R >> 12, t = R & 4095; n = b * 272 + 16 + (t >> 4); tau = t & 15; }
    else { const int r2 = R - MLAT, b = r2 >> 8, t = r2 & 255; n = b * 272 + (t >> 4); tau = t & 15; }
}

struct EpiStoreBf16 {
    static constexpr bool PERM = true;
    bf16_t* O; int ldc;
    DI void operator()(const AccT& acc, const Unit& u, int wr, int wc, int fr, int fq) const {
        const int row0 = u.pm * 256 + wr * 64 + fr, col0 = u.pn * 256 + wc * 32 + 8 * fq;
#pragma unroll
        for (int ai = 0; ai < 2; ++ai)
#pragma unroll
            for (int m = 0; m < 4; ++m) { bf16_t* rowp = O + (size_t)(row0 + ai * 128 + m * 16) * ldc + col0;
#pragma unroll
                for (int bj = 0; bj < 2; ++bj) { const f32x4 v0 = acc[ai][bj][m][0], v1 = acc[ai][bj][m][1];
                    u32x4 w; w.x = cvtpk(v0[0], v0[1]); w.y = cvtpk(v0[2], v0[3]); w.z = cvtpk(v1[0], v1[1]); w.w = cvtpk(v1[2], v1[3]);
                    *(u32x4*)(rowp + bj * 128) = w; } }
    }
};
struct EpiProjB {
    static constexpr bool PERM = false;
    bf16_t* A3; bf16_t* SG;
    DI void operator()(const AccT& acc, const Unit& u, int wr, int wc, int fr, int fq) const {
        const bool is_su = u.pn < 4;
#pragma unroll
        for (int ai = 0; ai < 2; ++ai)
#pragma unroll
            for (int m = 0; m < 4; ++m) {
                const int R = u.pm * 256 + ai * 128 + wr * 64 + m * 16 + fr;
                int n, tau; row_to_chunk(R, n, tau);
#pragma unroll
                for (int bj = 0; bj < 2; ++bj)
#pragma unroll
                    for (int nn = 0; nn < 2; ++nn) {
                        const int col = u.pn * 256 + bj * 128 + wc * 32 + nn * 16 + fq * 4;
                        const f32x4 v = acc[ai][bj][m][nn];
                        u32x2 w; w.x = cvtpk(v[0], v[1]); w.y = cvtpk(v[2], v[3]);
                        if (is_su) { const int g = col >> 4, c = col & 15; *(u32x2*)(A3 + ((size_t)(g * 1280 + n) * 512 + tau * 16 + c)) = w; }
                        else { *(u32x2*)(SG + (size_t)R * 1024 + (col - 1024)) = w; }
                    }
            }
    }
};
struct EpiOut0 {
    static constexpr bool PERM = false;
    const float* x; const float* ctx; const float* mod0; float* out; float* ctx1;
    DI void operator()(const AccT& acc, const Unit& u, int wr, int wc, int fr, int fq) const {
        const int R0 = u.pm * 256;
        const bool lat = R0 < MLAT;
        const int mrow = lat ? (R0 >> 12) : 4;
        const float* gate = mod0 + mrow * 6144 + 4096;
        const float* srcb = lat ? x + (size_t)R0 * DM : ctx + (size_t)(R0 - MLAT) * DM;
        float* dstb = lat ? out + (size_t)R0 * DM : ctx1 + (size_t)(R0 - MLAT) * DM;
        const int colb = u.pn * 256 + wc * 32 + fq * 4;
        f32x4 gv[2][2];
#pragma unroll
        for (int bj = 0; bj < 2; ++bj)
#pragma unroll
            for (int nn = 0; nn < 2; ++nn) gv[bj][nn] = *(const f32x4*)(gate + colb + bj * 128 + nn * 16);
#pragma unroll
        for (int ai = 0; ai < 2; ++ai) {
            f32x4 xv[4][2][2];
#pragma unroll
            for (int m = 0; m < 4; ++m)
#pragma unroll
                for (int bj = 0; bj < 2; ++bj)
#pragma unroll
                    for (int nn = 0; nn < 2; ++nn) xv[m][bj][nn] = *(const f32x4*)(srcb + (size_t)(ai * 128 + wr * 64 + m * 16 + fr) * DM + colb + bj * 128 + nn * 16);
#pragma unroll
            for (int m = 0; m < 4; ++m)
#pragma unroll
                for (int bj = 0; bj < 2; ++bj)
#pragma unroll
                    for (int nn = 0; nn < 2; ++nn) *(f32x4*)(dstb + (size_t)(ai * 128 + wr * 64 + m * 16 + fr) * DM + colb + bj * 128 + nn * 16) = xv[m][bj][nn] + gv[bj][nn] * acc[ai][bj][m][nn];
        }
    }
};


struct EpiS5E {
    static constexpr bool PERM = false;
    float* E;
    DI void operator()(const AccT& acc, const Unit& u, int wr, int wc, int fr, int fq) const {
        const int g = u.pn, tile = u.pm - 5 * g;
#pragma unroll
        for (int ai = 0; ai < 2; ++ai)
#pragma unroll
            for (int m = 0; m < 4; ++m) {
                const int n = tile * 256 + ai * 128 + wr * 64 + m * 16 + fr;
                if (n < 1088) {
                    float* rowp = E + (size_t)(g * 1088 + n) * 256;
#pragma unroll
                    for (int bj = 0; bj < 2; ++bj)
#pragma unroll
                        for (int nn = 0; nn < 2; ++nn) *(f32x4*)(rowp + bj * 128 + wc * 32 + nn * 16 + fq * 4) = acc[ai][bj][m][nn];
                }
            }
    }
};
struct EpiS5Y {
    static constexpr bool PERM = false;
    bf16_t* GB;
    DI void operator()(const AccT& acc, const Unit& u, int wr, int wc, int fr, int fq) const {
        const int g = u.pn, tile = u.pm - 5 * g;
#pragma unroll
        for (int ai = 0; ai < 2; ++ai)
#pragma unroll
            for (int m = 0; m < 4; ++m) {
                const int n = tile * 256 + ai * 128 + wr * 64 + m * 16 + fr;
                if (n < 1088) {
                    const int b = n / 272, kc = n - b * 272;
                    const int R0 = kc < 16 ? MLAT + b * 256 + kc * 16 : b * 4096 + (kc - 16) * 16;
#pragma unroll
                    for (int bj = 0; bj < 2; ++bj)
#pragma unroll
                        for (int nn = 0; nn < 2; ++nn) {
                            const int kk = bj * 128 + wc * 32 + nn * 16 + fq * 4, t = kk >> 4, co = kk & 15;
                            const f32x4 v = acc[ai][bj][m][nn];
                            u32x2 w; w.x = cvtpk(gelu_tanh(v[0]), gelu_tanh(v[1])); w.y = cvtpk(gelu_tanh(v[2]), gelu_tanh(v[3]));
                            *(u32x2*)(GB + (size_t)(R0 + t) * 1024 + g * 16 + co) = w;
                        }
                }
            }
    }
};
struct EpiGlu {
    static constexpr bool PERM = false;
    const bf16_t* GB; const bf16_t* SG; const float* bias; bf16_t* MIXED;
    DI void operator()(const AccT& acc, const Unit& u, int wr, int wc, int fr, int fq) const {
        const int colb = u.pn * 256 + wc * 32 + fq * 4;
        f32x4 bv[2][2];
#pragma unroll
        for (int bj = 0; bj < 2; ++bj)
#pragma unroll
            for (int nn = 0; nn < 2; ++nn) bv[bj][nn] = *(const f32x4*)(bias + colb + bj * 128 + nn * 16);
#pragma unroll
        for (int ai = 0; ai < 2; ++ai) {
            u32x2 gw[4][2][2], sw[4][2][2];
#pragma unroll
            for (int m = 0; m < 4; ++m) { const size_t R = (size_t)(u.pm * 256 + ai * 128 + wr * 64 + m * 16 + fr);
#pragma unroll
                for (int bj = 0; bj < 2; ++bj)
#pragma unroll
                    for (int nn = 0; nn < 2; ++nn) { const int col = colb + bj * 128 + nn * 16; gw[m][bj][nn] = *(const u32x2*)(GB + R * 1024 + col); sw[m][bj][nn] = *(const u32x2*)(SG + R * 1024 + col); } }
#pragma unroll
            for (int m = 0; m < 4; ++m) { const size_t R = (size_t)(u.pm * 256 + ai * 128 + wr * 64 + m * 16 + fr);
#pragma unroll
                for (int bj = 0; bj < 2; ++bj)
#pragma unroll
                    for (int nn = 0; nn < 2; ++nn) {
                        const int col = colb + bj * 128 + nn * 16;
                        const f32x4 v = acc[ai][bj][m][nn] + bv[bj][nn];
                        const u32x2 g = gw[m][bj][nn], sg = sw[m][bj][nn];
                        u32x2 w; w.x = cvtpk(bflo(g.x) * sigmoidf_(v[0]) * siluf_(bflo(sg.x)), bfhi(g.x) * sigmoidf_(v[1]) * siluf_(bfhi(sg.x)));
                        w.y = cvtpk(bflo(g.y) * sigmoidf_(v[2]) * siluf_(bflo(sg.y)), bfhi(g.y) * sigmoidf_(v[3]) * siluf_(bfhi(sg.y)));
                        *(u32x2*)(MIXED + R * 2048 + 1024 + col) = w;
                    } }
        }
    }
};

constexpr float QSCALE = 0.125f * 1.4426950408889634f;
constexpr float LAM_INIT = 0.35550906759096335f;
struct QKGOrder {
    pg8::StaticOrder S;
    __device__ bool next(int i, Unit& u) const { if (!S.next(i, u)) return false; if (u.pn >= 16) u.pn += 8; return true; }
};
struct EpiQKG {
    static constexpr bool PERM = true;
    bf16_t* Q; bf16_t* K; bf16_t* GATE; const float* qn; const float* kn; const float* rope; int row_off, pn_off;
    DI void operator()(const AccT& acc, const Unit& u, int wr, int wc, int fr, int fq) const {
        const int pn = u.pn + pn_off;
        if (pn >= 24) {
#pragma unroll
            for (int ai = 0; ai < 2; ++ai)
#pragma unroll
                for (int m = 0; m < 4; ++m) {
                    const int R = row_off + u.pm * 256 + ai * 128 + wr * 64 + m * 16 + fr;
#pragma unroll
                    for (int bj = 0; bj < 2; ++bj) {
                        const int col = (pn - 24) * 256 + bj * 128 + wc * 32 + 8 * fq;
                        const f32x4 v0 = acc[ai][bj][m][0], v1 = acc[ai][bj][m][1];
                        u32x4 w; w.x = cvtpk(siluf_(v0[0]), siluf_(v0[1])); w.y = cvtpk(siluf_(v0[2]), siluf_(v0[3])); w.z = cvtpk(siluf_(v1[0]), siluf_(v1[1])); w.w = cvtpk(siluf_(v1[2]), siluf_(v1[3]));
                        *(u32x4*)(GATE + (size_t)R * 2048 + col) = w;
                    }
                }
            return;
        }
        const bool isq = pn < 8;
        const int hm = 4 * (pn & 7) + wc, h = hm >> 1, mp = hm & 1;
        const float* nw = isq ? qn : kn;
        f32x4 w[2][2];
#pragma unroll
        for (int bj = 0; bj < 2; ++bj)
#pragma unroll
            for (int nn = 0; nn < 2; ++nn) w[bj][nn] = *(const f32x4*)(nw + 32 * bj + 16 * nn + 4 * fq);
#pragma unroll
        for (int ai = 0; ai < 2; ++ai) {
            const bool lat = (row_off + u.pm * 256) < MLAT;
            f32x4 cs[4][2], sn[4][2];
            if (lat) {
#pragma unroll
                for (int m = 0; m < 4; ++m) { const int t = (row_off + u.pm * 256 + ai * 128 + wr * 64 + m * 16 + fr) & 4095;
#pragma unroll
                    for (int bj = 0; bj < 2; ++bj) { const int pos = bj == 0 ? (t >> 6) : (t & 63); cs[m][bj] = *(const f32x4*)(rope + pos * 32 + 4 * fq); sn[m][bj] = *(const f32x4*)(rope + pos * 32 + 16 + 4 * fq); } }
            }
#pragma unroll
            for (int m = 0; m < 4; ++m) {
                const int R = row_off + u.pm * 256 + ai * 128 + wr * 64 + m * 16 + fr;
                float ss = 0.f;
#pragma unroll
                for (int bj = 0; bj < 2; ++bj)
#pragma unroll
                    for (int nn = 0; nn < 2; ++nn) { const f32x4 v = acc[ai][bj][m][nn]; ss += (v[0] * v[0] + v[1] * v[1]) + (v[2] * v[2] + v[3] * v[3]); }
                ss += __shfl_xor(ss, 16); ss += __shfl_xor(ss, 32);
                const float rstd = __builtin_amdgcn_rsqf(ss * (1.0f / 64.0f) + EPS);
                const int b = lat ? (R >> 12) : ((R - MLAT) >> 8);
                const int t = lat ? (R & 4095) : ((R - MLAT) & 255);
                bf16_t* dst = isq ? Q + ((size_t)((b * 16 + h) * 2 + mp) * 4096 + t) * 64
                                  : K + ((size_t)((b * 16 + h) * 2 + mp) * 4352 + (lat ? 256 + t : t)) * 64;
#pragma unroll
                for (int bj = 0; bj < 2; ++bj) {
                    f32x4 x1 = acc[ai][bj][m][0] * rstd * w[bj][0], x2 = acc[ai][bj][m][1] * rstd * w[bj][1];
                    if (lat) { const f32x4 o1 = x1 * cs[m][bj] - x2 * sn[m][bj], o2 = x1 * sn[m][bj] + x2 * cs[m][bj]; x1 = o1; x2 = o2; }
                    if (isq) { x1 = x1 * QSCALE; x2 = x2 * QSCALE; }
                    u32x2 p1, p2; p1.x = cvtpk(x1[0], x1[1]); p1.y = cvtpk(x1[2], x1[3]); p2.x = cvtpk(x2[0], x2[1]); p2.y = cvtpk(x2[2], x2[3]);
                    *(u32x2*)(dst + 32 * bj + 4 * fq) = p1; *(u32x2*)(dst + 32 * bj + 16 + 4 * fq) = p2;
                }
            }
        }
    }
};
struct EpiVT {
    static constexpr bool PERM = true;
    bf16_t* VT;
    DI void operator()(const AccT& acc, const Unit& u, int wr, int wc, int fr, int fq) const {
        const int R0 = u.pn * 256;
        const bool lat = R0 < MLAT;
        const int b = lat ? (R0 >> 12) : ((R0 - MLAT) >> 8);
        const int kv0 = lat ? 256 + (R0 & 4095) : ((R0 - MLAT) & 255);
#pragma unroll
        for (int ai = 0; ai < 2; ++ai)
#pragma unroll
            for (int m = 0; m < 4; ++m) {
                const int vc = u.pm * 256 + ai * 128 + wr * 64 + m * 16 + fr, h = vc >> 7, e = vc & 127;
                bf16_t* rowp = VT + ((size_t)((b * 16 + h) * 128 + e)) * 4352 + kv0 + wc * 32 + 8 * fq;
#pragma unroll
                for (int bj = 0; bj < 2; ++bj) { const f32x4 v0 = acc[ai][bj][m][0], v1 = acc[ai][bj][m][1];
                    u32x4 w; w.x = cvtpk(v0[0], v0[1]); w.y = cvtpk(v0[2], v0[3]); w.z = cvtpk(v1[0], v1[1]); w.w = cvtpk(v1[2], v1[3]);
                    *(u32x4*)(rowp + bj * 128) = w; }
            }
    }
};
struct EpiOut1 {
    static constexpr bool PERM = false;
    const float* mod1; float* out;
    DI void operator()(const AccT& acc, const Unit& u, int wr, int wc, int fr, int fq) const {
        const int R0 = u.pm * 256;
        const float* gate = mod1 + (R0 >> 12) * 6144 + 4096;
        float* dstb = out + (size_t)R0 * DM;
        const int colb = u.pn * 256 + wc * 32 + fq * 4;
        f32x4 gv[2][2];
#pragma unroll
        for (int bj = 0; bj < 2; ++bj)
#pragma unroll
            for (int nn = 0; nn < 2; ++nn) gv[bj][nn] = *(const f32x4*)(gate + colb + bj * 128 + nn * 16);
#pragma unroll
        for (int ai = 0; ai < 2; ++ai) {
            f32x4 xv[4][2][2];
#pragma unroll
            for (int m = 0; m < 4; ++m)
#pragma unroll
                for (int bj = 0; bj < 2; ++bj)
#pragma unroll
                    for (int nn = 0; nn < 2; ++nn) xv[m][bj][nn] = *(const f32x4*)(dstb + (size_t)(ai * 128 + wr * 64 + m * 16 + fr) * DM + colb + bj * 128 + nn * 16);
#pragma unroll
            for (int m = 0; m < 4; ++m)
#pragma unroll
                for (int bj = 0; bj < 2; ++bj)
#pragma unroll
                    for (int nn = 0; nn < 2; ++nn) *(f32x4*)(dstb + (size_t)(ai * 128 + wr * 64 + m * 16 + fr) * DM + colb + bj * 128 + nn * 16) = xv[m][bj][nn] + gv[bj][nn] * acc[ai][bj][m][nn];
        }
    }
};

struct EpiHyT {
    static constexpr bool PERM = false;
    bf16_t* O;
    DI void operator()(const AccT& acc, const Unit& u, int wr, int wc, int fr, int fq) const {
#pragma unroll
        for (int ai = 0; ai < 2; ++ai)
#pragma unroll
            for (int m = 0; m < 4; ++m) { bf16_t* rowp = O + (size_t)(u.pm * 256 + ai * 128 + wr * 64 + m * 16 + fr) * MTOT + u.pn * 256 + wc * 32 + 4 * fq;
#pragma unroll
                for (int bj = 0; bj < 2; ++bj)
#pragma unroll
                    for (int nn = 0; nn < 2; ++nn) { const f32x4 v = acc[ai][bj][m][nn]; u32x2 w; w.x = cvtpk(v[0], v[1]); w.y = cvtpk(v[2], v[3]); *(u32x2*)(rowp + bj * 128 + nn * 16) = w; } }
    }
};

struct EpiProjBP {
    static constexpr bool PERM = true;
    bf16_t* A3; bf16_t* SG;
    DI void operator()(const AccT& acc, const Unit& u, int wr, int wc, int fr, int fq) const {
        const bool is_su = u.pn < 4;
#pragma unroll
        for (int ai = 0; ai < 2; ++ai)
#pragma unroll
            for (int m = 0; m < 4; ++m) {
                const int R = u.pm * 256 + ai * 128 + wr * 64 + m * 16 + fr;
                int n, tau; row_to_chunk(R, n, tau);
#pragma unroll
                for (int bj = 0; bj < 2; ++bj) {
                    const int col = u.pn * 256 + bj * 128 + wc * 32 + 8 * fq;
                    const f32x4 v0 = acc[ai][bj][m][0], v1 = acc[ai][bj][m][1];
                    u32x4 w; w.x = cvtpk(v0[0], v0[1]); w.y = cvtpk(v0[2], v0[3]); w.z = cvtpk(v1[0], v1[1]); w.w = cvtpk(v1[2], v1[3]);
                    if (is_su) { const int g = col >> 4, c = col & 15; *(u32x4*)(A3 + ((size_t)(g * 1280 + n) * 512 + tau * 16 + c)) = w; }
                    else { *(u32x4*)(SG + (size_t)R * 1024 + (col - 1024)) = w; }
                }
            }
    }
};
struct P2Order { pg8::StaticOrder S0, S1; int G, c;
    __device__ bool next(int i, Unit& u) const { const long L = (long)i * G + c; if (L < S0.nwg) return S0.map(L, u); if (!S1.map(L - S0.nwg, u)) return false; u.kind = 1; return true; } };
struct EpiP2 { static constexpr bool PERM = true; EpiStoreBf16 e0; EpiProjBP e1;
    DI void operator()(const AccT& acc, const Unit& u, int wr, int wc, int fr, int fq) const { if (u.kind == 0) e0(acc, u, wr, wc, fr, fq); else e1(acc, u, wr, wc, fr, fq); } };
struct EpiVTn {
    static constexpr bool PERM = false;
    bf16_t* VT;
    DI void operator()(const AccT& acc, const Unit& u, int wr, int wc, int fr, int fq) const {
        const int R0 = u.pn * 256; const bool lat = R0 < MLAT;
        const int b = lat ? (R0 >> 12) : ((R0 - MLAT) >> 8);
        const int kv0 = lat ? 256 + (R0 & 4095) : ((R0 - MLAT) & 255);
#pragma unroll
        for (int ai = 0; ai < 2; ++ai)
#pragma unroll
            for (int m = 0; m < 4; ++m) {
                const int vc = u.pm * 256 + ai * 128 + wr * 64 + m * 16 + fr, h = vc >> 7, e = vc & 127;
                bf16_t* rowp = VT + ((size_t)((b * 16 + h) * 128 + e)) * 4352 + kv0 + wc * 32 + 4 * fq;
#pragma unroll
                for (int bj = 0; bj < 2; ++bj)
#pragma unroll
                    for (int nn = 0; nn < 2; ++nn) { const f32x4 v = acc[ai][bj][m][nn]; u32x2 w; w.x = cvtpk(v[0], v[1]); w.y = cvtpk(v[2], v[3]); *(u32x2*)(rowp + bj * 128 + nn * 16) = w; }
            }
    }
};
struct P7Order { pg8::StaticOrder Sa, Sb, Sc; int G, c;
    __device__ bool next(int i, Unit& u) const { long L = (long)i * G + c;
        if (L < Sa.nwg) { Sa.map(L, u); if (u.pn >= 16) u.pn += 8; return true; } L -= Sa.nwg;
        if (L < Sc.nwg) { Sc.map(L, u); u.kind = 2; return true; } L -= Sc.nwg;
        if (!Sb.map(L, u)) return false; u.kind = 1; return true; } };
struct EpiP7 { static constexpr bool PERM = true; EpiQKG ea; EpiVT ec;
    DI void operator()(const AccT& acc, const Unit& u, int wr, int wc, int fr, int fq) const {
        if (u.kind == 2) { ec(acc, u, wr, wc, fr, fq); return; }
        EpiQKG e = ea; e.row_off = u.kind ? MLAT : 0; e.pn_off = u.kind ? 8 : 0; e(acc, u, wr, wc, fr, fq); } };

template <bool QKPERM>
DI void transpose_item(const float* W, int K, int N, bf16_t* WT, LAS float* scr, int item, int lane) {
    const int nblk = N / 32, kb = item / nblk, nb = item % nblk, k0 = 64 * kb, n0 = 32 * nb;
#pragma unroll
    for (int i = 0; i < 32; ++i) { const int kk = 2 * i + (lane >> 5); scr[kk * 33 + (lane & 31)] = W[(size_t)(k0 + kk) * N + n0 + (lane & 31)]; }
    asm volatile("s_waitcnt lgkmcnt(0)" ::: "memory");
    const int c = lane & 7;
#pragma unroll
    for (int j = 0; j < 4; ++j) { const int n = (lane >> 3) + 8 * j; const LAS float* s = scr + (8 * c) * 33 + n;
        u32x4 o; o.x = cvtpk(s[0 * 33], s[1 * 33]); o.y = cvtpk(s[2 * 33], s[3 * 33]); o.z = cvtpk(s[4 * 33], s[5 * 33]); o.w = cvtpk(s[6 * 33], s[7 * 33]);
        int nr = n0 + n;
        if (QKPERM && nr < 4096) { const int cc = nr & 255, d = cc & 31; nr = (nr & ~255) + 128 * ((cc >> 5) & 1) + 32 * (cc >> 6) + 8 * ((d >> 2) & 3) + 4 * (d >> 4) + (d & 3); }
        *(u32x4*)(WT + (size_t)nr * K + k0 + 8 * c) = o; }
    asm volatile("s_waitcnt lgkmcnt(0)" ::: "memory");
}

struct Args { const float* in[38]; float* out; unsigned char* ws; };

enum { I_X = 0, I_C, I_CTX, I_CCTX, I_MODW, I_MODB, I_NORMW, I_EVIN, I_EVOUT, I_HYCW, I_HYCB, I_HYW1, I_HYB1, I_HYW2, I_HYB2, I_HYW3, I_HYB3, I_HYFREQ, I_HYSKIP,
       I_S5ARE, I_S5AIM, I_S5LOGDT, I_S5BRE, I_S5BIM, I_S5CRE, I_S5CIM, I_S5D, I_GLUW, I_GLUB, I_ODIN, I_ODOUT, I_QNORM, I_KNORM, I_LQ1, I_LK1, I_LQ2, I_LK2, I_SUBLN };

DI void mod_item(const Args& a, float* mod, LAS float* scr, int item, int lane) {
    const int kc = item & 31, cg_ = (item >> 5) % 24, l = item / (32 * 24);
    const float* cv = a.in[I_C]; const float* cc = a.in[I_CCTX];
    for (int e = lane; e < 5 * 64; e += 64) { const int r = e >> 6, k = kc * 64 + (e & 63); const float v = (r < 4) ? cv[r * DM + k] : cc[k]; scr[e] = siluf_(v); }
    asm volatile("s_waitcnt lgkmcnt(0)" ::: "memory");
    const float* W = a.in[I_MODW] + (size_t)l * DM * 6144 + (size_t)(kc * 64) * 6144 + cg_ * 256 + lane * 4;
    f32x4 acc[5];
#pragma unroll
    for (int r = 0; r < 5; ++r) acc[r] = (f32x4){0.f, 0.f, 0.f, 0.f};
#pragma unroll 16
    for (int k = 0; k < 64; ++k) { const f32x4 w = *(const f32x4*)(W + (size_t)k * 6144);
#pragma unroll
        for (int r = 0; r < 5; ++r) acc[r] += w * scr[r * 64 + k]; }
    const int col = cg_ * 256 + lane * 4;
    if (kc == 0) { const f32x4 b = *(const f32x4*)(a.in[I_MODB] + l * 6144 + col);
#pragma unroll
        for (int r = 0; r < 5; ++r) acc[r] += b; }
#pragma unroll
    for (int r = 0; r < 5; ++r)
#pragma unroll
        for (int e = 0; e < 4; ++e) unsafeAtomicAdd(mod + (size_t)(l * 5 + r) * 6144 + col + e, acc[r][e]);
    asm volatile("s_waitcnt lgkmcnt(0)" ::: "memory");
}
DI void h2_item(const Args& a, float* h2buf, LAS float* scr, const LAS float* w2s, int item, int lane) {
    const float* w1 = a.in[I_HYW1]; const float* fr = a.in[I_HYFREQ];
    float w1c[33];
#pragma unroll
    for (int i = 0; i < 33; ++i) w1c[i] = w1[i * 64 + lane];
    const float b1v = a.in[I_HYB1][lane], b2v = a.in[I_HYB2][lane], f0 = fr[lane], f1 = fr[64 + lane];
    const bool isctx = item >= 512; const int n = isctx ? 256 : 4096; const int t0 = (isctx ? item - 512 : item) * 8; const int row0 = (isctx ? 4096 : 0) + t0;
#pragma unroll 1
    for (int q = 0; q < 8; ++q) {
        const float tf = (float)(t0 + q);
        { const int i = lane & 15; const float band = 1e-4f + (float)i * ((15.0f - 1e-4f) / 15.0f); const float ang = (6.283185307179586f / (float)n) * tf * band;
          float fv = (lane < 16) ? cosf(ang) : -sinf(ang); if (lane == 32) fv = tf / (float)n; scr[lane] = fv; }
        asm volatile("s_waitcnt lgkmcnt(0)" ::: "memory");
        float s1 = b1v + scr[32] * w1c[0];
#pragma unroll
        for (int i = 0; i < 32; ++i) s1 += scr[i] * w1c[1 + i];
        const float h1 = sinf(f0 * s1);
        asm volatile("s_waitcnt lgkmcnt(0)" ::: "memory");
        scr[64 + lane] = h1;
        asm volatile("s_waitcnt lgkmcnt(0)" ::: "memory");
        float s2 = b2v;
#pragma unroll
        for (int i = 0; i < 64; ++i) s2 += scr[64 + i] * w2s[i * 64 + lane];
        h2buf[(size_t)(row0 + q) * 64 + lane] = sinf(f1 * s2);
        asm volatile("s_waitcnt lgkmcnt(0)" ::: "memory");
    }
}
DI void filt_item(const Args& a, const float* h2buf, bf16_t* glat, bf16_t* gctx, float* l1buf, int item, int lane) {
    const int lt = item >> 5, cgp = item & 31;
    const bool isctx = lt >= 128; const int lag0 = (isctx ? lt - 128 : lt) * 32, hrow0 = (isctx ? 4096 : 0) + lag0, n = isctx ? 256 : 4096;
    const int i32 = lane & 31, k2 = lane >> 5;
    float bv[32];
    { const float* hrow = h2buf + (size_t)(hrow0 + i32) * 64 + k2 * 32;
#pragma unroll
      for (int q = 0; q < 8; ++q) { const f32x4 v = *(const f32x4*)(hrow + 4 * q); bv[4 * q] = v[0]; bv[4 * q + 1] = v[1]; bv[4 * q + 2] = v[2]; bv[4 * q + 3] = v[3]; } }
    const int t = lag0 + i32; const float tn = (float)t / (float)n;
    const float da = -3.0701134573253944f, db = -15.350567286626972f;
    const int glen = isctx ? GCTX_LEN : GLAT_LEN;
    const float* w3 = a.in[I_HYW3]; const float* b3 = a.in[I_HYB3];
#pragma unroll 1
    for (int ct = 0; ct < 4; ++ct) {
        const int col0 = cgp * 128 + ct * 32;
        const float* wp = w3 + (size_t)(k2 * 32) * 4096 + col0 + i32;
        float av[32];
#pragma unroll
        for (int kk = 0; kk < 32; ++kk) av[kk] = wp[(size_t)kk * 4096];
        float b3v[16];
#pragma unroll
        for (int r = 0; r < 16; ++r) b3v[r] = b3[col0 + (r & 3) + 8 * (r >> 2) + 4 * k2];
        f32x16 acc;
#pragma unroll
        for (int r = 0; r < 16; ++r) acc[r] = 0.f;
#pragma unroll
        for (int kk = 0; kk < 32; ++kk) acc = __builtin_amdgcn_mfma_f32_32x32x2f32(av[kk], bv[kk], acc, 0, 0, 0);
        const int f = col0 >> 11, dir = (col0 >> 10) & 1, ch0 = col0 & 1023;
        bf16_t* gbase = isctx ? gctx + (size_t)(f * 1024 + ch0) * GCTX_LEN : glat + (size_t)(f * 1024 + ch0) * GLAT_LEN;
        const int idx = (dir == 0 ? 4223 - t : 4223 + t) - (isctx ? 3840 : 0);
        const bool store = !(dir == 1 && t == 0);
        float* l1p = l1buf + (size_t)lt * 4096 + col0;
        float vv[16], sm[16];
#pragma unroll
        for (int r = 0; r < 16; ++r) {
            const int cl = (r & 3) + 8 * (r >> 2) + 4 * k2;
            const float delta = fabsf(da + (float)(ch0 + cl) * ((db - da) / 1023.0f));
            vv[r] = (acc[r] + b3v[r]) * __expf(-tn * delta);
            sm[r] = store ? fabsf(vv[r]) : 0.f;
        }
        if (store) {
#pragma unroll
            for (int r = 0; r < 16; ++r) { const int cl = (r & 3) + 8 * (r >> 2) + 4 * k2; gbase[(size_t)cl * glen + idx] = (bf16_t)f2bf(vv[r]); }
        }
#pragma unroll
        for (int o = 1; o < 32; o <<= 1) {
            float tmp[16];
#pragma unroll
            for (int r = 0; r < 16; ++r) tmp[r] = __shfl_xor(sm[r], o);
#pragma unroll
            for (int r = 0; r < 16; ++r) sm[r] += tmp[r];
        }
        if (i32 == 0) {
#pragma unroll
            for (int r = 0; r < 16; ++r) l1p[(r & 3) + 8 * (r >> 2) + 4 * k2] = sm[r];
        }
    }
}
DI void modnorm_row(const float* xrow, const float* nw, const float* shift, const float* scale, bf16_t* orow, int lane) {
    f32x4 v[8], w[8], sh[8], sc[8]; float s = 0.f;
#pragma unroll
    for (int j = 0; j < 4; ++j) { const int col = 512 * j + 8 * lane; v[2 * j] = *(const f32x4*)(xrow + col); v[2 * j + 1] = *(const f32x4*)(xrow + col + 4); }
#pragma unroll
    for (int j = 0; j < 4; ++j) { const int col = 512 * j + 8 * lane;
        w[2 * j] = *(const f32x4*)(nw + col); w[2 * j + 1] = *(const f32x4*)(nw + col + 4); sh[2 * j] = *(const f32x4*)(shift + col); sh[2 * j + 1] = *(const f32x4*)(shift + col + 4);
        sc[2 * j] = *(const f32x4*)(scale + col); sc[2 * j + 1] = *(const f32x4*)(scale + col + 4); }
#pragma unroll
    for (int j = 0; j < 8; ++j) s += (v[j][0] * v[j][0] + v[j][1] * v[j][1]) + (v[j][2] * v[j][2] + v[j][3] * v[j][3]);
    const float rstd = __builtin_amdgcn_rsqf(wave_sum(s) * (1.0f / DM) + EPS);
#pragma unroll
    for (int j = 0; j < 4; ++j) { const int col = 512 * j + 8 * lane;
        const f32x4 y0 = (v[2 * j] * rstd) * w[2 * j] * (sc[2 * j] + 1.0f) + sh[2 * j], y1 = (v[2 * j + 1] * rstd) * w[2 * j + 1] * (sc[2 * j + 1] + 1.0f) + sh[2 * j + 1];
        u32x4 o; o.x = cvtpk(y0[0], y0[1]); o.y = cvtpk(y0[2], y0[3]); o.z = cvtpk(y1[0], y1[1]); o.w = cvtpk(y1[2], y1[3]);
        *(u32x4*)(orow + col) = o; }
}


typedef float cplx __attribute__((ext_vector_type(2)));
#define re x
#define im y
DI cplx cmul(cplx a, cplx b) { return (cplx){a.x * b.x - a.y * b.y, a.x * b.y + a.y * b.x}; }
DI void s5_ops_item(const Args& a, unsigned char* ws, LAS unsigned char* lds, int g) {
    const int tid = tid_opaque();
    LAS cplx* lamP = (LAS cplx*)lds;
    LAS cplx* Bb = (LAS cplx*)(lds + 17408);
    LAS cplx* Cc = (LAS cplx*)(lds + 17408 + 16384);
    LAS float* Kd = (LAS float*)(lds + 17408 + 32768);
    const float* are = a.in[I_S5ARE]; const float* aim = a.in[I_S5AIM]; const float* ldt = a.in[I_S5LOGDT];
    const float* bre = a.in[I_S5BRE]; const float* bim = a.in[I_S5BIM]; const float* cre = a.in[I_S5CRE]; const float* cim = a.in[I_S5CIM];
    __syncthreads();
    for (int e = tid; e < 2 * 17 * 64; e += NTHREADS) { const int dir = e / (17 * 64), dl = (e / 64) % 17, p = e & 63;
        const float dt = expf(ldt[dir * 64 + g]); const float ar = are[(dir * 64 + g) * 64 + p], ai = aim[(dir * 64 + g) * 64 + p];
        const float mag = expf((float)dl * dt * ar); float sn, cs; sincosf((float)dl * dt * ai, &sn, &cs);
        lamP[e] = (cplx){mag * cs, mag * sn}; }
    for (int e = tid; e < 2 * 64 * 16; e += NTHREADS) { const int dir = e / 1024, p = (e >> 4) & 63, c = e & 15;
        const float dt = expf(ldt[dir * 64 + g]); const float ar = are[(dir * 64 + g) * 64 + p], ai = aim[(dir * 64 + g) * 64 + p];
        const float mag = expf(dt * ar); float sn, cs; sincosf(dt * ai, &sn, &cs);
        const cplx lm1 = (cplx){mag * cs - 1.f, mag * sn}; const float den = ar * ar + ai * ai;
        const cplx q = (cplx){(lm1.re * ar + lm1.im * ai) / den, (lm1.im * ar - lm1.re * ai) / den};
        const size_t bi = ((size_t)(dir * 64 + g) * 64 + p) * 16 + c;
        Bb[e] = cmul(q, (cplx){bre[bi], bim[bi]}); }
    for (int e = tid; e < 2 * 16 * 64; e += NTHREADS) { const int dir = e / 1024, c = (e >> 6) & 15, p = e & 63;
        const size_t ci = ((size_t)(dir * 64 + g) * 16 + c) * 64 + p; Cc[e] = (cplx){cre[ci], cim[ci]}; }
    __syncthreads();
    for (int e = tid; e < 2 * 16 * 256; e += NTHREADS) { const int dir = e / 4096, dl = (e >> 8) & 15, co = (e >> 4) & 15, ci = e & 15;
        float acc = 0.f;
        for (int p = 0; p < 64; ++p) { const cplx t = cmul(Cc[(dir * 16 + co) * 64 + p], lamP[(dir * 17 + dl) * 64 + p]); const cplx b = Bb[(dir * 64 + p) * 16 + ci]; acc += t.re * b.re - t.im * b.im; }
        Kd[e] = acc; }
    __syncthreads();
    bf16_t* op3 = (bf16_t*)(ws + WS_OPA3) + (size_t)g * 256 * 512;
    const float* dvec = a.in[I_S5D] + g * 16;
    for (int e = tid; e < 256 * 256; e += NTHREADS) { const int row = e >> 8, kk2 = (e & 255) * 2; const int t = row >> 4, co = row & 15;
        float v[2];
#pragma unroll
        for (int q = 0; q < 2; ++q) { const int kk = kk2 + q; float val;
            if (kk < 256) { const int tau = kk >> 4, ci = kk & 15; val = 0.f;
                if (tau <= t) val += Kd[((0 * 16 + (t - tau)) * 16 + co) * 16 + ci];
                if (tau >= t) val += Kd[((1 * 16 + (tau - t)) * 16 + co) * 16 + ci];
                if (tau == t && co == ci) val += dvec[co]; }
            else { const int dir = (kk - 256) >> 7, part = ((kk - 256) >> 6) & 1, p = kk & 63;
                const cplx w = cmul(Cc[(dir * 16 + co) * 64 + p], lamP[(dir * 17 + (dir == 0 ? t + 1 : 16 - t)) * 64 + p]);
                val = part == 0 ? w.re : -w.im; }
            v[q] = val; }
        *(unsigned*)(op3 + (size_t)row * 512 + kk2) = cvtpk(v[0], v[1]); }
    bf16_t* op1 = (bf16_t*)(ws + WS_OPA1) + (size_t)g * 256 * 256;
    for (int e = tid; e < 256 * 128; e += NTHREADS) { const int row = e >> 7, kk2 = (e & 127) * 2; const int dir = row >> 7, part = (row >> 6) & 1, p = row & 63;
        float v[2];
#pragma unroll
        for (int q = 0; q < 2; ++q) { const int kk = kk2 + q, tau = kk >> 4, ci = kk & 15;
            const cplx w = cmul(lamP[(dir * 17 + (dir == 0 ? 15 - tau : tau)) * 64 + p], Bb[(dir * 64 + p) * 16 + ci]);
            v[q] = part == 0 ? w.re : w.im; }
        *(unsigned*)(op1 + (size_t)row * 256 + kk2) = cvtpk(v[0], v[1]); }
    float* lamL = (float*)(ws + WS_LAML) + (size_t)g * 256;
    for (int e = tid; e < 128; e += NTHREADS) { const int dir = e >> 6, p = e & 63; const cplx l = lamP[(dir * 17 + 16) * 64 + p]; lamL[e * 2] = l.re; lamL[e * 2 + 1] = l.im; }
    __syncthreads();
}
#undef re
#undef im
DI void s5_scan_item(unsigned char* ws, int item, int lane) {
    const int dir = item & 1, g = (item >> 1) & 63, b = item >> 7;
    const float* lamL = (const float*)(ws + WS_LAML) + (size_t)g * 256 + (dir * 64 + lane) * 2;
    const float lr = lamL[0], li = lamL[1];
    const float* E = (const float*)(ws + WS_E) + (size_t)(g * 1088 + b * 272) * 256 + dir * 128 + lane;
    bf16_t* A3 = (bf16_t*)(ws + WS_A3) + (size_t)(g * 1280 + b * 272) * 512 + 256 + dir * 128 + lane;
    float sr = 0.f, si = 0.f;
#pragma unroll 1
    for (int s0 = 0; s0 < 272; s0 += 16) {
        float er[16], ei[16]; int kcs[16];
#pragma unroll
        for (int q = 0; q < 16; ++q) { const int s = s0 + q; const int kc = dir == 0 ? s : (s < 16 ? 15 - s : 287 - s); kcs[q] = kc; er[q] = E[(size_t)kc * 256]; ei[q] = E[(size_t)kc * 256 + 64]; }
#pragma unroll
        for (int q = 0; q < 16; ++q) { bf16_t* o = A3 + (size_t)kcs[q] * 512; o[0] = (bf16_t)f2bf(sr); o[64] = (bf16_t)f2bf(si);
            const float nr = lr * sr - li * si + er[q], ni = lr * si + li * sr + ei[q]; sr = nr; si = ni; }
    }
}

constexpr int HY_UROW = 528;
constexpr int HY_JS = 36;
constexpr int HY_GRAW_OFF = 4 * HY_JS * HY_UROW;
constexpr int HY_WIN_OFF = HY_GRAW_OFF + 16960;
constexpr int HY_GRAW2_OFF = HY_WIN_OFF + 8 * 2 * 1024;
constexpr int HY_LDS = HY_GRAW2_OFF + 16960;
static_assert(HY_LDS + 128 <= LDS_BYTES - 64, "hyena LDS");
DI int crow(int r, int hi) { return (r & 3) + 8 * (r >> 2) + 4 * hi; }

DI void sconv8(const bf16_t* p, int t, int n, float w0, float w1, float w2, float bb, float (&o)[8]) {
    const u32x4 m = *(const u32x4*)p; const float um = t > 0 ? bf2f(p[-1]) : 0.f, up = t + 8 < n ? bf2f(p[8]) : 0.f;
    const float x[10] = {um, bflo(m.x), bfhi(m.x), bflo(m.y), bfhi(m.y), bflo(m.z), bfhi(m.z), bflo(m.w), bfhi(m.w), up};
#pragma unroll
    for (int i = 0; i < 8; ++i) o[i] = w0 * x[i] + w1 * x[i + 1] + w2 * x[i + 2] + bb;
}
template <bool isctx>
DI void hyena_item(const Args& a, unsigned char* ws, LAS unsigned char* lds, int item, bool do_store) {
    const int tid = tid_opaque(), lane = tid & 63, wid = __builtin_amdgcn_readfirstlane(tid >> 6);
    const int c = item & 1023;
    constexpr int NI = isctx ? 1 : 16, n = NI * 256, JJ = HY_JS, NGRP = 4 * n / 8, NITER = (NGRP + NTHREADS - 1) / NTHREADS;
    bf16_t* hpt = (bf16_t*)(ws + WS_HPT);
    const float* cw = a.in[I_HYCW]; const float* cb = a.in[I_HYCB];
    constexpr int rbase = isctx ? MLAT : 0;
    constexpr int goff = isctx ? 3840 : 0, glen = isctx ? GCTX_LEN : GLAT_LEN;
    LAS float* red = (LAS float*)(lds + HY_LDS);
    {
        const float* l1part = (const float*)(ws + WS_L1P) + (size_t)(isctx ? 128 : 0) * 4096;
        constexpr int NLT = isctx ? 8 : 128; const int lt_ = tid >> 1, dir_ = tid & 1;
        float v0_ = 0.f, v1_ = 0.f;
        if (lt_ < NLT) { v0_ = l1part[(size_t)lt_ * 4096 + dir_ * 1024 + c]; v1_ = l1part[(size_t)lt_ * 4096 + 2048 + dir_ * 1024 + c]; }
        u32x4 gq[2][3];
#pragma unroll
        for (int f = 0; f < 2; ++f) { const bf16_t* Gsrc = isctx ? (const bf16_t*)(ws + WS_GCTX) + (size_t)(f * 1024 + c) * GCTX_LEN : (const bf16_t*)(ws + WS_GLAT) + (size_t)(f * 1024 + c) * GLAT_LEN;
#pragma unroll
            for (int it = 0; it < (isctx ? 1 : 3); ++it) { const int p = tid + it * NTHREADS; if (p < glen / 8) gq[f][it] = *(const u32x4*)(Gsrc + 8 * p); } }
        { constexpr int RW = HY_UROW / 4, NPR = JJ - NI;
          for (int e = tid; e < 4 * NPR * RW; e += NTHREADS) { const int r = e / RW, w_ = e - r * RW, bb_ = r / NPR, pr = r - bb_ * NPR, jj = pr < 7 ? pr : pr + NI;
              ((LAS unsigned*)lds)[(bb_ * JJ + jj) * RW + w_] = 0u; } }
#pragma unroll
        for (int f = 0; f < 2; ++f)
#pragma unroll
            for (int it = 0; it < (isctx ? 1 : 3); ++it) { const int p = tid + it * NTHREADS; if (p < glen / 8) *(LAS u32x4*)(lds + (f == 0 ? HY_GRAW_OFF : HY_GRAW2_OFF) + 16 * p) = gq[f][it]; }
        v0_ = wave_sum(v0_); v1_ = wave_sum(v1_);
        if (lane == 0) { red[wid] = v0_; red[8 + wid] = v1_; }
    }
    __syncthreads();
    {
        const float w0 = cw[c], w1 = cw[3072 + c], w2 = cw[6144 + c], bb = cb[c];
        const bf16_t* src = hpt + (size_t)c * MTOT + rbase;
#pragma unroll
        for (int it = 0; it < NITER; ++it) { const int e = tid + it * NTHREADS;
            if (e < NGRP) { const int b = e / (n >> 3), t = 8 * (e % (n >> 3)); float o[8]; sconv8(src + b * n + t, t, n, w0, w1, w2, bb, o);
                u32x4 w; w.x = cvtpk(o[0], o[1]); w.y = cvtpk(o[2], o[3]); w.z = cvtpk(o[4], o[5]); w.w = cvtpk(o[6], o[7]);
                *(LAS u32x4*)(lds + (b * JJ + (t >> 8) + 7) * HY_UROW + (t & 255) * 2) = w; } }
    }
    __syncthreads();
    const int ip = lane & 31, hi = lane >> 5, rho = wid;
    LAS unsigned char* win = lds + HY_WIN_OFF + wid * 2048;
    const float* skip = a.in[I_HYSKIP];
    const bf16_t* sgate = hpt + (size_t)(3072 + c) * MTOT + rbase;
    const int il = ip >> 2, bt = ip & 3;
#pragma unroll 1
    for (int f = 0; f < 2; ++f) {
        const int graw = f == 0 ? HY_GRAW_OFF : HY_GRAW2_OFF;
        f32x16 acc0, acc1;
#pragma unroll
        for (int r = 0; r < 16; ++r) { acc0[r] = 0.f; acc1[r] = 0.f; }
        const int sodd = (3975 - rho - goff) & 1;
        unsigned wd[5];
#define HY_LOADW(d_) do { const int base_ = 3975 - 256 * (d_) - rho - goff; const LAS unsigned* gp_ = (const LAS unsigned*)(lds + graw) + ((base_ - sodd) >> 1) + 4 * lane; \
            wd[0] = gp_[0]; wd[1] = gp_[1]; wd[2] = gp_[2]; wd[3] = gp_[3]; wd[4] = gp_[4]; } while (0)
#define HY_STOREW(buf_) do { u32x4 w_; if (sodd) { w_.x = __builtin_amdgcn_alignbit(wd[1], wd[0], 16); w_.y = __builtin_amdgcn_alignbit(wd[2], wd[1], 16); w_.z = __builtin_amdgcn_alignbit(wd[3], wd[2], 16); w_.w = __builtin_amdgcn_alignbit(wd[4], wd[3], 16); } \
            else { w_.x = wd[0]; w_.y = wd[1]; w_.z = wd[2]; w_.w = wd[3]; } *(LAS u32x4*)(win + (buf_) * 1024 + 16 * lane) = w_; } while (0)
        int buf = 0;
        HY_LOADW(-(NI - 1)); HY_STOREW(0);
#pragma unroll 1
        for (int d = -(NI - 1); d <= NI - 1; ++d) {
            if (d < NI - 1) HY_LOADW(d + 1);
            const LAS unsigned char* wb = win + buf * 1024 + 2 * (248 - 8 * ip + 8 * hi);
            const bool val0 = (7 - d >= 0) && (0 - d <= NI - 1);
            const bool val1 = (NI > 8) && (15 - d >= 0) && (8 - d <= NI - 1);
            const LAS unsigned char* ub0 = lds + (bt * JJ + (il - d + 7)) * HY_UROW + 16 * hi;
            const LAS unsigned char* ub1 = ub0 + 8 * HY_UROW;
#pragma unroll
            for (int kh = 0; kh < 2; ++kh) {
                bf16x8 af[8], b0[8], b1[8];
#pragma unroll
                for (int k = 0; k < 8; ++k) af[k] = *(const LAS bf16x8*)(wb + 32 * (8 * kh + k));
                if (val0) {
#pragma unroll
                    for (int k = 0; k < 8; ++k) b0[k] = *(const LAS bf16x8*)(ub0 + 32 * (8 * kh + k));
                }
                if (val1) {
#pragma unroll
                    for (int k = 0; k < 8; ++k) b1[k] = *(const LAS bf16x8*)(ub1 + 32 * (8 * kh + k));
                }
                __builtin_amdgcn_sched_barrier(0);
                if (val0) {
#pragma unroll
                    for (int k = 0; k < 8; ++k) acc0 = __builtin_amdgcn_mfma_f32_32x32x16_bf16(af[k], b0[k], acc0, 0, 0, 0);
                }
                if (val1) {
#pragma unroll
                    for (int k = 0; k < 8; ++k) acc1 = __builtin_amdgcn_mfma_f32_32x32x16_bf16(af[k], b1[k], acc1, 0, 0, 0);
                }
                __builtin_amdgcn_sched_barrier(0);
            }
            if (d < NI - 1) HY_STOREW(buf ^ 1);
            buf ^= 1;
        }
#undef HY_LOADW
#undef HY_STOREW
        __syncthreads();
        const LAS float* rf = red + 8 * f;
        const float inv_l1 = 1.0f / (((rf[0] + rf[1]) + (rf[2] + rf[3])) + ((rf[4] + rf[5]) + (rf[6] + rf[7])));
        const float sk = skip[f * 1024 + c];
#pragma unroll
        for (int ib = 0; ib < 2; ++ib) {
            const int i = 8 * ib + il;
            if (i < NI) {
#pragma unroll
                for (int r = 0; r < 16; ++r) {
                    const int aa = 8 * crow(r, hi) + rho;
                    LAS bf16_t* up = (LAS bf16_t*)(lds + (bt * JJ + i + 7) * HY_UROW + aa * 2);
                    const float av = ib == 0 ? acc0[r] : acc1[r];
                    *up = (bf16_t)f2bf(av * inv_l1 + sk * bf2f(*up));
                }
            }
        }
        __syncthreads();
        {
            const int pc = (f + 1) * 1024 + c;
            const float w0 = cw[pc], w1 = cw[3072 + pc], w2 = cw[6144 + pc], bb = cb[pc];
            const bf16_t* xsrc = hpt + (size_t)pc * MTOT + rbase;
            bf16_t* ydst = hpt + (size_t)c * MTOT + rbase;
#pragma unroll
            for (int it = 0; it < NITER; ++it) { const int e = tid + it * NTHREADS;
                if (e < NGRP) { const int b = e / (n >> 3), t = 8 * (e % (n >> 3)); float o[8]; sconv8(xsrc + b * n + t, t, n, w0, w1, w2, bb, o);
                    LAS u32x4* up = (LAS u32x4*)(lds + (b * JJ + (t >> 8) + 7) * HY_UROW + (t & 255) * 2);
                    const u32x4 uw = *up;
                    const float z[8] = {o[0] * bflo(uw.x), o[1] * bfhi(uw.x), o[2] * bflo(uw.y), o[3] * bfhi(uw.y), o[4] * bflo(uw.z), o[5] * bfhi(uw.z), o[6] * bflo(uw.w), o[7] * bfhi(uw.w)};
                    if (f == 0) { u32x4 w; w.x = cvtpk(z[0], z[1]); w.y = cvtpk(z[2], z[3]); w.z = cvtpk(z[4], z[5]); w.w = cvtpk(z[6], z[7]); *up = w; }
                    else { const u32x4 hw = *(const u32x4*)(sgate + b * n + t); u32x4 w;
                        w.x = cvtpk(z[0] * siluf_(bflo(hw.x)), z[1] * siluf_(bfhi(hw.x))); w.y = cvtpk(z[2] * siluf_(bflo(hw.y)), z[3] * siluf_(bfhi(hw.y)));
                        w.z = cvtpk(z[4] * siluf_(bflo(hw.z)), z[5] * siluf_(bfhi(hw.z))); w.w = cvtpk(z[6] * siluf_(bflo(hw.w)), z[7] * siluf_(bfhi(hw.w)));
                        if (do_store) *(u32x4*)(ydst + b * n + t) = w; } } }
        }
        __syncthreads();
    }
}
DI void hy_transpose_item(unsigned char* ws, LAS unsigned char* scr, int item, int lane) {
    const int ct = item & 15, rt = item >> 4, c0 = ct * 64, R0 = rt * 64;
    const bf16_t* hpt = (const bf16_t*)(ws + WS_HPT); bf16_t* mixed = (bf16_t*)(ws + WS_MIXED);
    const int pc = lane & 7, rg = lane >> 3;
#pragma unroll
    for (int j = 0; j < 8; ++j) { const int row = 8 * j + rg; *(LAS u32x4*)(scr + row * 144 + pc * 16) = *(const u32x4*)(hpt + (size_t)(c0 + row) * MTOT + R0 + 8 * pc); }
    asm volatile("s_waitcnt lgkmcnt(0)" ::: "memory");
#pragma unroll
    for (int j = 0; j < 8; ++j) { const int R = 8 * j + rg;
        unsigned short v[8];
#pragma unroll
        for (int i = 0; i < 8; ++i) v[i] = *(const LAS unsigned short*)(scr + (8 * pc + i) * 144 + R * 2);
        u32x4 w; w.x = (unsigned)v[0] | ((unsigned)v[1] << 16); w.y = (unsigned)v[2] | ((unsigned)v[3] << 16); w.z = (unsigned)v[4] | ((unsigned)v[5] << 16); w.w = (unsigned)v[6] | ((unsigned)v[7] << 16);
        *(u32x4*)(mixed + (size_t)(R0 + R) * 2048 + c0 + 8 * pc) = w; }
    asm volatile("s_waitcnt lgkmcnt(0)" ::: "memory");
}

constexpr int AT_ROWB = 144;
constexpr int AT_KOFF = 0, AT_VOFF = 2 * 64 * AT_ROWB, AT_BUF = AT_VOFF + 128 * AT_ROWB;
constexpr int AT_LOFF = 3 * AT_BUF;
constexpr int NKV = 4352, NKT = NKV / 64;
DI void attn_unit(unsigned char* ws, LAS unsigned char* lds, int b, int h, int qb, float lam, const float* subln) {
    const int tid = tid_opaque(), lane = tid & 63, wid = __builtin_amdgcn_readfirstlane(tid >> 6);
    const int mp = wid >> 2, wq = wid & 3, i32 = lane & 31, hi = lane >> 5;
    const bf16_t* Qg = (const bf16_t*)(ws + WS_Q) + ((size_t)((b * 16 + h) * 2 + mp) * 4096 + qb * 128 + wq * 32) * 64;
    const bf16_t* Kg = (const bf16_t*)(ws + WS_K) + (size_t)((b * 16 + h) * 2) * NKV * 64;
    const bf16_t* Vg = (const bf16_t*)(ws + WS_VT) + (size_t)((b * 16 + h) * 128) * NKV;
    bf16x8 qf[4];
#pragma unroll
    for (int d0 = 0; d0 < 4; ++d0) qf[d0] = *(const bf16x8*)(Qg + i32 * 64 + d0 * 16 + hi * 8);
    const bf16_t* ksrc[2]; const bf16_t* vsrc[2]; int kdst[2], vdst[2];
#pragma unroll
    for (int j = 0; j < 2; ++j) { const int idx = tid + 512 * j;
        const int mm = idx >> 9, row = (idx >> 3) & 63, pc = idx & 7;
        ksrc[j] = Kg + ((size_t)mm * NKV + row) * 64 + pc * 8; kdst[j] = AT_KOFF + mm * 64 * AT_ROWB + row * AT_ROWB + pc * 16;
        const int e = idx >> 3;
        vsrc[j] = Vg + (size_t)e * NKV + pc * 8; vdst[j] = AT_VOFF + e * AT_ROWB + pc * 16; }
    u32x4 kr[2], vr[2];
#pragma unroll
    for (int j = 0; j < 2; ++j) { kr[j] = *(const u32x4*)ksrc[j]; vr[j] = *(const u32x4*)vsrc[j]; }
#pragma unroll
    for (int j = 0; j < 2; ++j) { *(LAS u32x4*)(lds + kdst[j]) = kr[j]; *(LAS u32x4*)(lds + vdst[j]) = vr[j]; }
#pragma unroll
    for (int j = 0; j < 2; ++j) { kr[j] = *(const u32x4*)(ksrc[j] + (size_t)64 * 64); vr[j] = *(const u32x4*)(vsrc[j] + 64); }
#pragma unroll
    for (int j = 0; j < 2; ++j) { *(LAS u32x4*)(lds + AT_BUF + kdst[j]) = kr[j]; *(LAS u32x4*)(lds + AT_BUF + vdst[j]) = vr[j]; }
    __syncthreads();
    const int pi = (i32 & 0x13) | ((i32 & 8) >> 1) | ((i32 & 4) << 1);
    const int koff = AT_KOFF + mp * 64 * AT_ROWB + pi * AT_ROWB + hi * 16;
    const int voff = AT_VOFF + i32 * AT_ROWB + hi * 16;
    f32x16 o[4];
#pragma unroll
    for (int d = 0; d < 4; ++d)
#pragma unroll
        for (int r = 0; r < 16; ++r) o[d][r] = 0.f;
    f32x16 pA[2], pB[2];
    f32x2_t ls2 = {0.f, 0.f};
    const f32x16 zero16 = {0.f, 0.f, 0.f, 0.f, 0.f, 0.f, 0.f, 0.f, 0.f, 0.f, 0.f, 0.f, 0.f, 0.f, 0.f, 0.f};
#define AT_QK(P, bufoff) do { _Pragma("unroll") for (int half = 0; half < 2; ++half) { \
        _Pragma("unroll") for (int d0 = 0; d0 < 4; ++d0) { const bf16x8 kf = *(const LAS bf16x8*)(lds + (bufoff) + koff + half * 32 * AT_ROWB + d0 * 32); \
            P[half] = __builtin_amdgcn_mfma_f32_32x32x16_bf16(kf, qf[d0], d0 == 0 ? zero16 : P[half], 0, 0, 0); } } } while (0)
#define AT_EXPH(PC, half, pa) do { \
            _Pragma("unroll") for (int r = 0; r < 16; r += 2) { PC[half][r] = __builtin_amdgcn_exp2f(PC[half][r]); PC[half][r + 1] = __builtin_amdgcn_exp2f(PC[half][r + 1]); ls2 += (f32x2_t){PC[half][r], PC[half][r + 1]}; } \
            _Pragma("unroll") for (int ks = 0; ks < 2; ++ks) { u32x4 w; w.x = cvtpk(PC[half][8 * ks], PC[half][8 * ks + 1]); w.y = cvtpk(PC[half][8 * ks + 2], PC[half][8 * ks + 3]); \
                w.z = cvtpk(PC[half][8 * ks + 4], PC[half][8 * ks + 5]); w.w = cvtpk(PC[half][8 * ks + 6], PC[half][8 * ks + 7]); pa[ks] = __builtin_bit_cast(bf16x8, w); } } while (0)
#define AT_STEP(PC, PN, t) do { \
        if ((t) + 2 < NKT) { _Pragma("unroll") for (int j = 0; j < 2; ++j) { kr[j] = *(const u32x4*)(ksrc[j] + (size_t)((t) + 2) * 64 * 64); vr[j] = *(const u32x4*)(vsrc[j] + ((t) + 2) * 64); } } \
        bf16x8 kfr[8], pa0[2], pa1[2]; \
        _Pragma("unroll") for (int q = 0; q < 8; ++q) kfr[q] = *(const LAS bf16x8*)(lds + bn + koff + (q >> 2) * 32 * AT_ROWB + (q & 3) * 32); \
        __builtin_amdgcn_sched_barrier(0); \
        AT_EXPH(PC, 0, pa0); \
        if ((t) + 1 < NKT) { _Pragma("unroll") for (int q = 0; q < 8; ++q) PN[q >> 2] = __builtin_amdgcn_mfma_f32_32x32x16_bf16(kfr[q], qf[q & 3], (q & 3) == 0 ? zero16 : PN[q >> 2], 0, 0, 0); } \
        _Pragma("unroll") for (int q = 0; q < 8; ++q) { const bf16x8 vf_ = *(const LAS bf16x8*)(lds + bc + voff + (q >> 1) * 32 * AT_ROWB + (q & 1) * 32); o[q >> 1] = __builtin_amdgcn_mfma_f32_32x32x16_bf16(pa0[q & 1], vf_, o[q >> 1], 0, 0, 0); } \
        AT_EXPH(PC, 1, pa1); \
        _Pragma("unroll") for (int q = 0; q < 8; ++q) { const bf16x8 vf_ = *(const LAS bf16x8*)(lds + bc + voff + (q >> 1) * 32 * AT_ROWB + 64 + (q & 1) * 32); o[q >> 1] = __builtin_amdgcn_mfma_f32_32x32x16_bf16(pa1[q & 1], vf_, o[q >> 1], 0, 0, 0); } \
        if ((t) + 2 < NKT) { _Pragma("unroll") for (int j = 0; j < 2; ++j) { *(LAS u32x4*)(lds + bw + kdst[j]) = kr[j]; *(LAS u32x4*)(lds + bw + vdst[j]) = vr[j]; } } \
        __syncthreads(); \
        { const int tmp_ = bc; bc = bn; bn = bw; bw = tmp_; } } while (0)
    int bc = 0, bn = AT_BUF, bw = 2 * AT_BUF;
    AT_QK(pA, 0);
#pragma unroll 1
    for (int t = 0; t < NKT; t += 2) {
        AT_STEP(pA, pB, t);
        AT_STEP(pB, pA, t + 1);
    }
    const float lsum0 = ls2[0] + ls2[1];
    float lsum = lsum0;
#undef AT_QK
#undef AT_STEP
#undef AT_EXPH
    lsum += __shfl_xor(lsum, 32);
    LAS float* ls = (LAS float*)(lds + AT_LOFF) + wid * 32;
    if (hi == 0) ls[i32] = 1.0f / lsum;
    asm volatile("s_waitcnt lgkmcnt(0)" ::: "memory");
    float rl[16];
#pragma unroll
    for (int r = 0; r < 16; ++r) rl[r] = ls[crow(r, hi)];
    LAS float* X = (LAS float*)lds + wq * 32 * 128;
    if (mp == 1) {
#pragma unroll
        for (int db = 0; db < 4; ++db)
#pragma unroll
            for (int r = 0; r < 16; ++r) X[crow(r, hi) * 128 + db * 32 + i32] = o[db][r] * rl[r] * lam;
    }
    __syncthreads();
    if (mp == 0) {
        float ss[16];
#pragma unroll
        for (int r = 0; r < 16; ++r) { float acc = 0.f;
#pragma unroll
            for (int db = 0; db < 4; ++db) { const float v = o[db][r] * rl[r] - X[crow(r, hi) * 128 + db * 32 + i32]; o[db][r] = v; acc += v * v; }
            ss[r] = acc; }
#pragma unroll
        for (int r = 0; r < 16; ++r) {
#pragma unroll
            for (int off = 1; off < 32; off <<= 1) ss[r] += __shfl_xor(ss[r], off);
            ss[r] = (1.0f - LAM_INIT) / sqrtf(ss[r] * (1.0f / 128.0f) + EPS); }
        const bf16_t* gate = (const bf16_t*)(ws + WS_GATE1); bf16_t* AO = (bf16_t*)(ws + WS_AO);
        const size_t ibase = ((size_t)b * 4096 + qb * 128 + wq * 32) * 2048 + h * 128 + i32;
        bf16_t gvv[4][16];
#pragma unroll
        for (int db = 0; db < 4; ++db)
#pragma unroll
            for (int r = 0; r < 16; ++r) gvv[db][r] = gate[ibase + (size_t)crow(r, hi) * 2048 + db * 32];
#pragma unroll
        for (int db = 0; db < 4; ++db) { const float sw = subln[db * 32 + i32];
#pragma unroll
            for (int r = 0; r < 16; ++r) AO[ibase + (size_t)crow(r, hi) * 2048 + db * 32] = (bf16_t)f2bf(o[db][r] * ss[r] * sw * bf2f(gvv[db][r])); }
    }
    __syncthreads();
}

#define XB_TMO      128
#define XB_XCNT(j)  (256  + 64 * (j))
#define XB_XSUB(j)  (1280 + 64 * (j))
#define XB_XGEN(j)  (2304 + 64 * (j))
#define XB_TOP      3328
#define XB_TOPGEN   3392
#define XCD_BAR_WORDS 3456
#define XB_SPIN_CAP (1u << 22)
DI unsigned xb_ld(unsigned* p)              { return __hip_atomic_load(p, __ATOMIC_RELAXED, __HIP_MEMORY_SCOPE_AGENT); }
DI unsigned xb_add(unsigned* p, unsigned v) { return __hip_atomic_fetch_add(p, v, __ATOMIC_RELAXED, __HIP_MEMORY_SCOPE_AGENT); }
DI unsigned xb_xcc_id() { return (unsigned)__builtin_amdgcn_s_getreg((3 << 11) | 20) & 0xFu; }
#define XB_SPIN(cond, bar) do { unsigned _sp = 0; while (cond) { __builtin_amdgcn_s_sleep(1); \
    if ((++_sp & 255u) == 0u) { if (xb_ld(&(bar)[XB_TMO])) break; if (_sp > XB_SPIN_CAP) { atomicAdd(&(bar)[XB_TMO], 1u); break; } } } } while (0)
struct XcdBarrier { unsigned* bar; unsigned x; volatile LAS unsigned* st; };
DI XcdBarrier xcd_barrier_post(unsigned* bar, volatile LAS unsigned* st) {
    XcdBarrier b; b.bar = bar; b.x = xb_xcc_id(); b.st = st;
    if (threadIdx.x == 0) (void)xb_add(&bar[XB_XCNT(b.x)], 1u);
    return b;
}
DI void xcd_barrier_complete(unsigned* bar, unsigned x, unsigned& nloc, unsigned& nx) {
    const unsigned G = gridDim.x * gridDim.y * gridDim.z;
    unsigned sum, cnt, mine, sp = 0u;
    for (;;) {
        sum = 0u; cnt = 0u; mine = 0u;
#pragma unroll
        for (unsigned j = 0; j < 16; ++j) { const unsigned c = xb_ld(&bar[XB_XCNT(j)]); sum += c; cnt += (c > 0u) ? 1u : 0u; mine = (j == x) ? c : mine; }
        if (sum == G) break;
        __builtin_amdgcn_s_sleep(1);
        if ((++sp & 255u) == 0u) { if (xb_ld(&bar[XB_TMO])) break; if (sp > XB_SPIN_CAP) { atomicAdd(&bar[XB_TMO], 1u); break; } }
    }
    nloc = mine > 0u ? mine : 1u; nx = cnt > 0u ? cnt : 1u;
}
DI void xcd_barrier(const XcdBarrier& b) {
    asm volatile("s_waitcnt vmcnt(0)" ::: "memory");
    __syncthreads();
    if (threadIdx.x == 0) {
        unsigned* bar = b.bar;
        __builtin_amdgcn_s_waitcnt(0);
        unsigned nloc = b.st[0], nx = b.st[1];
        if (nloc == 0u) { xcd_barrier_complete(bar, b.x, nloc, nx); b.st[0] = nloc; b.st[1] = nx; }
        const unsigned old = xb_add(&bar[XB_XSUB(b.x)], 1u);
        const unsigned gen = old / nloc;
        if (old + 1u == (gen + 1u) * nloc) {
            __builtin_amdgcn_fence(__ATOMIC_RELEASE, "agent");
            asm volatile("s_waitcnt vmcnt(0)" ::: "memory");
            const unsigned og = xb_add(&bar[XB_TOP], 1u);
            const unsigned tg = og / nx;
            if (og + 1u == (tg + 1u) * nx) xb_add(&bar[XB_TOPGEN], 1u);
            else XB_SPIN(xb_ld(&bar[XB_TOPGEN]) == tg, bar);
            __builtin_amdgcn_fence(__ATOMIC_ACQUIRE, "agent");
            xb_add(&bar[XB_XGEN(b.x)], 1u);
            asm volatile("s_waitcnt vmcnt(0)" ::: "memory");
        } else {
            XB_SPIN(xb_ld(&bar[XB_XGEN(b.x)]) == gen, bar);
            __builtin_amdgcn_fence(__ATOMIC_ACQUIRE, "agent");
            asm volatile("s_waitcnt vmcnt(0)" ::: "memory");
        }
    }
    __syncthreads();
}

__global__ void __launch_bounds__(NTHREADS, 2) fwd_kernel(Args a) {
    extern __shared__ __attribute__((aligned(16))) unsigned char lds_raw[];
    LAS unsigned char* lds = (LAS unsigned char*)lds_raw;
    cg::grid_group grid = cg::this_grid();
    const int G = gridDim.x, bid = blockIdx.x;
#define PHASE_IDS const int tid = tid_opaque(), lane = tid & 63, wid = __builtin_amdgcn_readfirstlane(tid >> 6), gw = bid * NWAVES + wid, NGW = G * NWAVES; (void)tid; (void)lane; (void)gw; (void)NGW;
    unsigned char* ws = a.ws;
    volatile LAS unsigned* bst = (volatile LAS unsigned*)(lds + LDS_BYTES - 64);
    if (threadIdx.x < 16) bst[threadIdx.x] = 0u;
    __syncthreads();
    const XcdBarrier xbar = xcd_barrier_post((unsigned*)(ws + OFF_BAR), bst);
#define GRID_BAR() xcd_barrier(xbar)
    float* mod = (float*)(ws + OFF_MOD);
    bf16_t* HN = (bf16_t*)(ws + WS_HN);

#ifndef SKIP_P0
    for (int g = G - 1 - bid; g < 64; g += G) s5_ops_item(a, ws, lds, g);
    __syncthreads();
    {
        PHASE_IDS
        LAS float* scr = (LAS float*)(lds + wid * 8704);
        LAS float* w2s = (LAS float*)(lds + 69632);
        { const float* w2 = a.in[I_HYW2]; for (int e = tid; e < 4096; e += NTHREADS) w2s[e] = w2[e]; }
        __syncthreads();
        constexpr int I_A = (2048 / 64) * (6144 / 32), I_B = (2048 / 64) * (2048 / 32), I_C2 = (1024 / 64) * (1024 / 32), I_M = 2 * 24 * 32, I_H = 544;
                if (gw == NGW - 1) { float* rp = (float*)(ws + WS_ROPE); for (int e = lane; e < 1024; e += 64) { const int pos = e >> 4, i = e & 15; const float fr_ = expf(-(float)i * (9.210340371976184f / 16.0f)); float sn, cs; sincosf((float)pos * fr_, &sn, &cs); rp[pos * 32 + i] = cs; rp[pos * 32 + 16 + i] = sn; } }
        for (int it = gw; it < I_M; it += NGW) mod_item(a, mod, scr, it, lane);
        for (int it = gw; it < I_H; it += NGW) h2_item(a, (float*)(ws + WS_H2), scr, w2s, I_H - 1 - it, lane);
        constexpr int NTR = I_A + I_B + I_C2;
        const int NTW = (G > 128 ? G - 64 : G) * NWAVES;
        for (int it = gw; it < NTR && gw < NTW; it += NTW) {
            int r = it;
            if (r < I_A) { transpose_item<false>(a.in[I_EVIN], 2048, 6144, (bf16_t*)(ws + WS_EVIN_T), scr, r, lane); continue; } r -= I_A;
            if (r < I_B) { transpose_item<false>(a.in[I_EVOUT], 2048, 2048, (bf16_t*)(ws + WS_EVOUT_T), scr, r, lane); continue; } r -= I_B;
            transpose_item<false>(a.in[I_GLUW], 1024, 1024, (bf16_t*)(ws + WS_GLU_T), scr, r, lane);
        }

    }
#endif
    grid.sync();
#ifndef SKIP_P1
    {
        PHASE_IDS
        {
            bf16_t* glat = (bf16_t*)(ws + WS_GLAT); bf16_t* gctx = (bf16_t*)(ws + WS_GCTX);
            const int gt = bid * NTHREADS + tid, GT = G * NTHREADS;
            for (int e = gt; e < 2048 * 258; e += GT) { const int fc = e / 258, q = e % 258; const int idx = q < 128 ? q : 8319 + (q - 128); if (idx < GLAT_LEN) glat[(size_t)fc * GLAT_LEN + idx] = 0; }
            for (int e = gt; e < 2048 * 258; e += GT) { const int fc = e / 258, q = e % 258; const int idx = q < 128 ? q : 639 + (q - 128); if (idx < GCTX_LEN) gctx[(size_t)fc * GCTX_LEN + idx] = 0; }
        }
        constexpr int NF = 136 * 32;
        for (int it = gw; it < NF; it += NGW) filt_item(a, (const float*)(ws + WS_H2), (bf16_t*)(ws + WS_GLAT), (bf16_t*)(ws + WS_GCTX), (float*)(ws + WS_L1P), it, lane);
        const float* nw = a.in[I_NORMW];
        for (int rep = 0; rep < REP_P1M; ++rep)
        for (int R = gw; R < MTOT; R += NGW) {
            const bool lat = R < MLAT; const int mrow = lat ? (R >> 12) : 4;
            const float* xr = lat ? a.in[I_X] + (size_t)R * DM : a.in[I_CTX] + (size_t)(R - MLAT) * DM;
            modnorm_row(xr, nw, mod + mrow * 6144, mod + mrow * 6144 + 2048, HN + (size_t)R * DM, lane);
        }
    }
#endif
    GRID_BAR();
#ifndef SKIP_P2
    {
        const bf16_t* WT = (const bf16_t*)(ws + WS_EVIN_T);
        { pg8::Gemm g{WT, HN, 2048, 2048, 2048, HN, WT + (size_t)4096 * 2048, nullptr, nullptr};
          P2Order S; S.S0.init(4096, MTOT, G, bid); S.S1.init(MTOT, 2048, G, bid); S.G = G; S.c = bid;
          EpiP2 E{EpiStoreBf16{(bf16_t*)(ws + WS_HPT), MTOT}, EpiProjBP{(bf16_t*)(ws + WS_A3), (bf16_t*)(ws + WS_SG)}};
          pg8::gemm_phase<EpiP2, P2Order>(lds, g, S, E); }
    }
#endif
    GRID_BAR();
#ifndef SKIP_P3
    {
#ifndef SKIP_S5A
        { pg8::Gemm g{(const bf16_t*)(ws + WS_A3), (const bf16_t*)(ws + WS_OPA1), 512, 256, 256}; pg8::S5Order S{G, bid};
          EpiS5E E{(float*)(ws + WS_E)};
          pg8::gemm_phase<EpiS5E, pg8::S5Order>(lds, g, S, E); }
#endif
        for (int rep = 0; rep < REP_HY; ++rep) {
        for (int it = bid; it < 1024; it += G) hyena_item<false>(a, ws, lds, it, rep == REP_HY - 1);
        for (int it = bid; it < 1024; it += G) hyena_item<true>(a, ws, lds, 1024 + it, rep == REP_HY - 1); }
    }
#endif
    GRID_BAR();
#ifndef SKIP_S5B
    for (int rep = 0; rep < REP_P3B; ++rep)
    { PHASE_IDS for (int it = gw; it < 512; it += NGW) s5_scan_item(ws, it, lane);
      LAS unsigned char* scr = lds + wid * 9216;
      if (NGW > 1024) { if (gw >= 512) for (int it = gw - 512; it < 4352; it += NGW - 512) hy_transpose_item(ws, scr, it, lane); }
      else { for (int it = NGW - 1 - gw; it < 4352; it += NGW) hy_transpose_item(ws, scr, it, lane); }
      { constexpr int I_A = (2048 / 64) * (8192 / 32), I_B = (2048 / 64) * (2048 / 32);
        const int nscan = NGW > 1024 ? 512 : 0;
        if (gw >= nscan) for (int it = gw - nscan; it < I_A + I_B; it += NGW - nscan) {
            if (it < I_A) transpose_item<true>(a.in[I_ODIN], 2048, 8192, (bf16_t*)(ws + WS_ODIN_T), (LAS float*)scr, it, lane);
            else transpose_item<false>(a.in[I_ODOUT], 2048, 2048, (bf16_t*)(ws + WS_ODOUT_T), (LAS float*)scr, it - I_A, lane); } } }
#endif
    GRID_BAR();
#ifndef SKIP_S5C
    { pg8::Gemm g{(const bf16_t*)(ws + WS_A3), (const bf16_t*)(ws + WS_OPA3), 512, 512, 512}; pg8::S5Order S{G, bid};
      EpiS5Y E{(bf16_t*)(ws + WS_GB)};
      pg8::gemm_phase<EpiS5Y, pg8::S5Order>(lds, g, S, E); }
#endif
    GRID_BAR();
#ifndef SKIP_P4
    { pg8::Gemm g{(const bf16_t*)(ws + WS_GB), (const bf16_t*)(ws + WS_GLU_T), 1024, 1024, 1024}; pg8::StaticOrder S; S.init(MTOT, 1024, G, bid);
      EpiGlu E{(const bf16_t*)(ws + WS_GB), (const bf16_t*)(ws + WS_SG), a.in[I_GLUB], (bf16_t*)(ws + WS_MIXED)};
      pg8::gemm_phase<EpiGlu, pg8::StaticOrder>(lds, g, S, E); }
#endif
    GRID_BAR();
#ifndef SKIP_P5
    for (int rep = 0; rep < REP_P57; ++rep)
    {
        pg8::Gemm g{(const bf16_t*)(ws + WS_MIXED), (const bf16_t*)(ws + WS_EVOUT_T), 2048, 2048, 2048}; pg8::StaticOrder S; S.init(MTOT, 2048, G, bid);
        EpiOut0 E{a.in[I_X], a.in[I_CTX], mod, a.out, (float*)(ws + WS_CTX1)};
        pg8::gemm_phase<EpiOut0, pg8::StaticOrder>(lds, g, S, E);
    }
#endif
    GRID_BAR();
    for (int rep = 0; rep < REP_P6; ++rep)
    {
        PHASE_IDS
        LAS float* scr = (LAS float*)(lds + wid * 16768);
        const float* nw = a.in[I_NORMW] + DM; const float* mod1 = mod + 5 * 6144;
        for (int R = gw; R < MTOT; R += NGW) {
            const bool lat = R < MLAT; const int mrow = lat ? (R >> 12) : 4;
            const float* xr = lat ? a.out + (size_t)R * DM : (const float*)(ws + WS_CTX1) + (size_t)(R - MLAT) * DM;
            modnorm_row(xr, nw, mod1 + mrow * 6144, mod1 + mrow * 6144 + 2048, HN + (size_t)R * DM, lane);
        }
    }
    GRID_BAR();
    for (int rep = 0; rep < REP_P57; ++rep)
    {
        const bf16_t* WT = (const bf16_t*)(ws + WS_ODIN_T);
        const float* rope = (const float*)(ws + WS_ROPE);
        { pg8::Gemm g{HN, WT, 2048, 2048, 2048, HN + (size_t)MLAT * 2048, WT + (size_t)2048 * 2048, WT + (size_t)4096 * 2048, HN};
          P7Order S; S.Sa.init(MLAT, 24 * 256, G, bid); S.Sb.init(MCTX, 2048, G, bid); S.Sc.init(2048, MTOT, G, bid); S.G = G; S.c = bid;
          EpiQKG Ea{(bf16_t*)(ws + WS_Q), (bf16_t*)(ws + WS_K), (bf16_t*)(ws + WS_GATE1), a.in[I_QNORM], a.in[I_KNORM], rope, 0, 0};
          EpiP7 E{Ea, EpiVT{(bf16_t*)(ws + WS_VT)}};
          pg8::gemm_phase<EpiP7, P7Order>(lds, g, S, E); }
    }
    GRID_BAR();
    for (int rep = 0; rep < EXTRA_SYNC; ++rep) GRID_BAR();
    {
        float d1 = 0.f, d2 = 0.f;
        { const float* q1 = a.in[I_LQ1]; const float* k1 = a.in[I_LK1]; const float* q2 = a.in[I_LQ2]; const float* k2 = a.in[I_LK2];
          for (int i = 0; i < 64; ++i) { d1 += q1[i] * k1[i]; d2 += q2[i] * k2[i]; } }
        const float lam = expf(d1) - expf(d2) + LAM_INIT;
        for (int rep = 0; rep < REP_ATTN; ++rep)
        for (int u = bid; u < 2048; u += G) attn_unit(ws, lds, u >> 9, (u >> 5) & 15, u & 31, lam, a.in[I_SUBLN]);
    }
    GRID_BAR();
    {
        pg8::Gemm g{(const bf16_t*)(ws + WS_AO), (const bf16_t*)(ws + WS_ODOUT_T), 2048, 2048, 2048}; pg8::StaticOrder S; S.init(MLAT, 2048, G, bid);
        EpiOut1 E{mod + 5 * 6144, a.out};
        pg8::gemm_phase<EpiOut1, pg8::StaticOrder>(lds, g, S, E);
    }
}


extern "C" void kernel_launch(void* const* d_in, const int* in_sizes, int n_in, void* d_out, int out_size, void* d_ws, size_t ws_size, hipStream_t stream) {
    static int grid = 0;
    if (grid == 0) {
        int dev = 0, cus = 0, per_cu = 0;
        hipGetDevice(&dev);
        hipDeviceGetAttribute(&cus, hipDeviceAttributeMultiprocessorCount, dev);
        hipFuncSetAttribute((const void*)fwd_kernel, hipFuncAttributeMaxDynamicSharedMemorySize, LDS_BYTES);
        hipOccupancyMaxActiveBlocksPerMultiprocessor(&per_cu, (const void*)fwd_kernel, NTHREADS, LDS_BYTES);
        (void)hipGetLastError();
        grid = cus;
        if (ws_size < WS_NEED) { fprintf(stderr, "kernel_launch: workspace too small: %zu < %zu\n", ws_size, (size_t)WS_NEED); grid = -1; }
    }
    if (grid < 0) return;
    hipMemsetAsync((char*)d_ws + WS_CTL, 0, CTL_ZERO_BYTES, stream);
    Args a{};
    for (int i = 0; i < 38 && i < n_in; ++i) a.in[i] = (const float*)d_in[i];
    a.out = (float*)d_out; a.ws = (unsigned char*)d_ws;
    void* args[] = {&a};
    hipError_t e = hipLaunchCooperativeKernel((const void*)fwd_kernel, dim3(grid), dim3(NTHREADS), args, LDS_BYTES, stream);
    if (e != hipSuccess) fprintf(stderr, "cooperative launch failed: %s\n", hipGetErrorString(e));
}
```
